# Optimizing an MI355X kernel written in HIP

```python
import math
import jax, jax.numpy as jnp
from jax import lax
import numpy as np

D_MODEL = 1024
BATCH = 8
SEQ = 4096
DEPTH = 1
DEC_BATCH = 32
DEC_SEQ = 16
PAST_LEN = 2048

CHUNK = 64
Q_BLOCK = 128
HD = 64
FOX_HEADS = 8
FOX_WIDTH = FOX_HEADS * HD
DIFF_HEADS = 4
DIFF_WIDTH = DIFF_HEADS * 2 * HD
N_BUCKETS = 32
MAX_DISTANCE = 128
NORM_EPS = 1e-6
SCALE = HD ** -0.5
NEG_INF = -1e30

_SIZES = (FOX_WIDTH, FOX_WIDTH, FOX_WIDTH, FOX_WIDTH, FOX_HEADS,
          DIFF_WIDTH, DIFF_WIDTH, DIFF_WIDTH, DIFF_WIDTH, D_MODEL, D_MODEL)
IN_WIDTH = sum(_SIZES)
SPLIT_POINTS = tuple(sum(_SIZES[:i + 1]) for i in range(len(_SIZES) - 1))

kernel_name = "fox_diffattn_gated_hybrid_stream_step"


def rmsnorm(x, g):
    xf = x.astype(jnp.float32)
    y = xf * lax.rsqrt(jnp.mean(xf * xf, axis=-1, keepdims=True) + NORM_EPS) * g.astype(jnp.float32)
    return y.astype(x.dtype)


def t5_bucket(rel):
    nb = N_BUCKETS // 2
    side = jnp.where(rel > 0, nb, 0)
    n = jnp.abs(rel)
    max_exact = nb // 2
    large = max_exact + (jnp.log(jnp.maximum(n, 1).astype(jnp.float32) / max_exact)
                         / math.log(MAX_DISTANCE / max_exact) * (nb - max_exact)).astype(jnp.int32)
    large = jnp.minimum(large, nb - 1)
    return side + jnp.where(n < max_exact, n, large)


def sweep_queries(fn, qpos, *q_args):
    T = qpos.shape[0]
    if T <= Q_BLOCK or T % Q_BLOCK != 0:
        return fn(qpos, *q_args)
    nb = T // Q_BLOCK
    blk = lambda a: jnp.moveaxis(a.reshape(a.shape[0], nb, Q_BLOCK, *a.shape[2:]), 1, 0)
    out = lax.map(lambda args: fn(*args), (qpos.reshape(nb, Q_BLOCK),) + tuple(blk(a) for a in q_args))
    out = jnp.moveaxis(out, 0, 1)
    return out.reshape(out.shape[0], T, *out.shape[3:])


def _layer(x, past_fk, past_fv, past_fl, past_dk, past_dv, norm_g, w_in, b_f,
           lq1, lk1, lq2, lk2, subln_g, w_up_f, w_up_d, w_o, rel_bias, lambda_init):
    B, T, _ = x.shape
    P = past_fk.shape[1]
    dt = x.dtype
    f32 = jnp.float32
    h = rmsnorm(x, norm_g)
    proj = h @ w_in
    fq, fk, fv, fz, fl, dq, dk, dv, dz, ga, gb = jnp.split(proj, SPLIT_POINTS, axis=-1)
    fq = fq.reshape(B, T, FOX_HEADS, HD)
    fk = fk.reshape(B, T, FOX_HEADS, HD)
    fv = fv.reshape(B, T, FOX_HEADS, HD)
    logf = jax.nn.log_sigmoid((fl + b_f).astype(f32))
    dq = dq.reshape(B, T, DIFF_HEADS, 2, HD)
    dk = dk.reshape(B, T, DIFF_HEADS, 2, HD)
    dv = dv.reshape(B, T, DIFF_HEADS, 2 * HD)
    qpos = P + jnp.arange(T, dtype=jnp.int32)
    kpos = jnp.arange(P + T, dtype=jnp.int32)

    kf = jnp.concatenate([past_fk, fk], axis=1).astype(f32)
    vf = jnp.concatenate([past_fv, fv], axis=1).astype(f32)
    cum = lax.cumsum(jnp.concatenate([past_fl.astype(f32), logf], axis=1), axis=1)
    ck = jnp.swapaxes(cum, 1, 2)
    cq = cum[:, P:]

    def fox_block(qp, q, c):
        s = jnp.einsum('bqhd,bkhd->bhqk', q.astype(f32), kf) * SCALE
        s = s + jnp.swapaxes(c, 1, 2)[..., :, None] - ck[:, :, None, :]
        s = jnp.where(kpos[None, :] <= qp[:, None], s, NEG_INF)
        p = jax.nn.softmax(s, axis=-1)
        return jnp.einsum('bhqk,bkhd->bqhd', p, vf)

    of = sweep_queries(fox_block, qpos, fq, cq)

    kd = jnp.concatenate([past_dk, dk], axis=1).astype(f32)
    vd = jnp.concatenate([past_dv, dv], axis=1).astype(f32)
    lam = (jnp.exp(jnp.sum(lq1.astype(f32) * lk1.astype(f32)))
           - jnp.exp(jnp.sum(lq2.astype(f32) * lk2.astype(f32))) + lambda_init)
    table = rel_bias.astype(f32)

    def diff_block(qp, q):
        s = jnp.einsum('bqhmd,bkhmd->bhmqk', q.astype(f32), kd) * SCALE
        bias = table[t5_bucket(kpos[None, :] - qp[:, None])]
        s = s + jnp.transpose(bias, (2, 0, 1))[None, :, None]
        mask = (kpos[None, :] // CHUNK) <= (qp[:, None] // CHUNK)
        s = jnp.where(mask, s, NEG_INF)
        p = jax.nn.softmax(s, axis=-1)
        a = p[:, :, 0] - lam * p[:, :, 1]
        return jnp.einsum('bhqk,bkhe->bqhe', a, vd)

    od = sweep_queries(diff_block, qpos, dq)
    od = rmsnorm(od, subln_g) * (1.0 - lambda_init)

    yf = of.reshape(B, T, FOX_WIDTH).astype(dt) * jax.nn.silu(fz)
    yd = od.reshape(B, T, DIFF_WIDTH).astype(dt) * jax.nn.silu(dz)
    merged = jax.nn.sigmoid(ga) * (yf @ w_up_f) + jax.nn.sigmoid(gb) * (yd @ w_up_d)
    out = x + merged @ w_o
    return out, (fk, fv, logf.astype(dt), dk, dv)


def setup_inputs(seed: int = 0) -> dict:
    key = jax.random.key(seed)
    ks = jax.random.split(key, 24)
    nrm = lambda k, shape, s=1.0: jax.random.normal(k, shape, jnp.float32) * s
    return {
        "x_prompt": nrm(ks[0], (BATCH, SEQ, D_MODEL)),
        "x_sample": nrm(ks[1], (DEC_BATCH, DEC_SEQ, D_MODEL)),
        "cache_fox_k": nrm(ks[2], (DEPTH, DEC_BATCH, PAST_LEN, FOX_HEADS, HD)),
        "cache_fox_v": nrm(ks[3], (DEPTH, DEC_BATCH, PAST_LEN, FOX_HEADS, HD)),
        "cache_fox_logf": jax.nn.log_sigmoid(3.0 + nrm(ks[4], (DEPTH, DEC_BATCH, PAST_LEN, FOX_HEADS))),
        "cache_diff_k": nrm(ks[5], (DEPTH, DEC_BATCH, PAST_LEN, DIFF_HEADS, 2, HD)),
        "cache_diff_v": nrm(ks[6], (DEPTH, DEC_BATCH, PAST_LEN, DIFF_HEADS, 2 * HD)),
        "norm_in_g": 1.0 + nrm(ks[7], (DEPTH, D_MODEL), 0.05),
        "w_in": nrm(ks[8], (DEPTH, D_MODEL, IN_WIDTH), D_MODEL ** -0.5),
        "b_forget": 3.0 + nrm(ks[9], (DEPTH, FOX_HEADS), 0.5),
        "lambda_q1": nrm(ks[10], (DEPTH, HD), 0.1),
        "lambda_k1": nrm(ks[11], (DEPTH, HD), 0.1),
        "lambda_q2": nrm(ks[12], (DEPTH, HD), 0.1),
        "lambda_k2": nrm(ks[13], (DEPTH, HD), 0.1),
        "subln_g": 1.0 + nrm(ks[14], (DEPTH, 2 * HD), 0.05),
        "w_up_fox": nrm(ks[15], (DEPTH, FOX_WIDTH, D_MODEL), FOX_WIDTH ** -0.5),
        "w_up_diff": nrm(ks[16], (DEPTH, DIFF_WIDTH, D_MODEL), DIFF_WIDTH ** -0.5),
        "w_o": nrm(ks[17], (DEPTH, D_MODEL, D_MODEL), D_MODEL ** -0.5),
        "rel_bias": nrm(ks[18], (N_BUCKETS, DIFF_HEADS), 0.5),
        "final_norm_g": 1.0 + nrm(ks[19], (D_MODEL,), 0.05),
    }


def reference(x_prompt, x_sample, cache_fox_k, cache_fox_v, cache_fox_logf, cache_diff_k, cache_diff_v,
              norm_in_g, w_in, b_forget, lambda_q1, lambda_k1, lambda_q2, lambda_k2, subln_g,
              w_up_fox, w_up_diff, w_o, rel_bias, final_norm_g):
    hp, hs = x_prompt, x_sample
    Bp = x_prompt.shape[0]
    dt = x_prompt.dtype
    new_p, new_s = [], []
    for l in range(DEPTH):
        lambda_init = 0.8 - 0.6 * math.exp(-0.3 * l)
        w = (norm_in_g[l], w_in[l], b_forget[l], lambda_q1[l], lambda_k1[l], lambda_q2[l], lambda_k2[l],
             subln_g[l], w_up_fox[l], w_up_diff[l], w_o[l], rel_bias, lambda_init)
        hp, st_p = _layer(hp,
                          jnp.zeros((Bp, 0, FOX_HEADS, HD), dt), jnp.zeros((Bp, 0, FOX_HEADS, HD), dt),
                          jnp.zeros((Bp, 0, FOX_HEADS), dt),
                          jnp.zeros((Bp, 0, DIFF_HEADS, 2, HD), dt), jnp.zeros((Bp, 0, DIFF_HEADS, 2 * HD), dt),
                          *w)
        hs, st_s = _layer(hs, cache_fox_k[l], cache_fox_v[l], cache_fox_logf[l], cache_diff_k[l], cache_diff_v[l], *w)
        new_p.append(st_p)
        new_s.append(st_s)
    y_prompt = rmsnorm(hp, final_norm_g)
    y_sample = rmsnorm(hs, final_norm_g)
    stk = lambda states, i: jnp.stack([s[i] for s in states], axis=0)
    fox_k_p, fox_v_p, fox_logf_p, diff_k_p, diff_v_p = (stk(new_p, 0), stk(new_p, 1), stk(new_p, 2), stk(new_p, 3), stk(new_p, 4))
    fox_k_s, fox_v_s, fox_logf_s, diff_k_s, diff_v_s = (stk(new_s, 0), stk(new_s, 1), stk(new_s, 2), stk(new_s, 3), stk(new_s, 4))
    return (y_prompt, y_sample, fox_k_p, fox_v_p, fox_logf_p, diff_k_p, diff_v_p,
            fox_k_s, fox_v_s, fox_logf_s, diff_k_s, diff_v_s)
```

```cpp
#include <hip/hip_runtime.h>
#include <hip/hip_cooperative_groups.h>
#include <cstdio>
#include <cstdint>
#include <cmath>
namespace cg = cooperative_groups;

namespace pg8 {
#define PG8_LAS __attribute__((address_space(3)))
typedef unsigned short bf16_t;
typedef short bf16x8 __attribute__((ext_vector_type(8)));
typedef float f32x4 __attribute__((ext_vector_type(4)));
typedef unsigned u32x4 __attribute__((ext_vector_type(4)));
constexpr int BM = 256, BK = 64, HALF = 128, HTB = HALF * BK * 2  , STAGE_BYTES = 8 * HTB, NXCD = 8, WGM = 8;

__host__ __device__ __forceinline__ int lds_byte(int r, int c) { const int st = (r >> 4) * 2 + (c >> 5), rr = r & 15, cc = c & 31, ob = rr * 64 + cc * 2; return st * 1024 + (ob ^ (((ob >> 9) & 1) << 5)); }
__host__ __device__ __forceinline__ void stage_rc(int b, int& R, int& C) { const int st = b / 1024, sb = b % 1024, swz = sb ^ (((sb >> 9) & 1) << 5); R = (st >> 1) * 16 + swz / 64; C = (st & 1) * 32 + (swz % 64) / 2; }
__host__ __device__ __forceinline__ int perm32(int rho) { const int n = rho >> 4, i = rho & 15; return 8 * (i >> 2) + 4 * n + (i & 3); }

struct Unit { int pm, pn; };
struct Gemm { const bf16_t* A; const bf16_t* Bt; int M, N, K, lda, ldb; };

struct StaticOrder {
    int nM, nN, nwg, G, c;
    __host__ __device__ void init(int M, int N, int G_, int c_) { nM = M / BM; nN = N / BM; nwg = nM * nN; G = G_; c = c_; }
    __host__ __device__ bool next(int i, Unit& u) const {
        const long L = (long)i * G + c; if (L >= nwg) return false;
        int wgid = (int)L; { const int q = nwg / NXCD, r = nwg % NXCD, xcd = wgid % NXCD, off = wgid / NXCD; wgid = (xcd < r ? xcd * (q + 1) : r * (q + 1) + (xcd - r) * q) + off; }
        const int nig = WGM * nN, gid = wgid / nig, fm = gid * WGM, gsz = (nM - fm) < WGM ? (nM - fm) : WGM;
        u.pm = fm + ((wgid % nig) % gsz); u.pn = (wgid % nig) / gsz; return true;
    }
    __device__ __forceinline__ void a_ready(const Unit&) const {}
    __device__ __forceinline__ void done(const Unit&) const {}
};


template <class Epi, class Sched, bool ALIGN_EPI = false, bool SP2 = false>
__device__ __forceinline__ void gemm_phase(PG8_LAS unsigned char* lds, const Gemm g, const Sched& S, const Epi& E) {
    const int tid = threadIdx.x, wid = __builtin_amdgcn_readfirstlane(tid >> 6), lane = tid & 63, wr = wid >> 2, wc = wid & 3, fr = lane & 15, fq = lane >> 4;
    const int K = g.K, nt = K / BK;
    unsigned voffA[2], voffB[2];
#pragma unroll
    for (int i = 0; i < 2; ++i) { int R, C; stage_rc(tid * 16 + i * 8192, R, C); const int Rb = Epi::PERM ? ((R & ~31) + perm32(R & 31)) : R;
        voffA[i] = (unsigned)(R * g.lda + C) * 2u; voffB[i] = (unsigned)(Rb * g.ldb + C) * 2u; }
    const size_t kstep = (size_t)(BK * 2);
    const size_t hstepA = (size_t)HALF * g.lda * 2, hstepB = (size_t)HALF * g.ldb * 2;
    const size_t tstepA = 2 * hstepA, tstepB = 2 * hstepB;
    const unsigned ldsw = (unsigned)wid * 1024u;
    const int aoff = lds_byte(wr * 64 + fr, fq * 8), boff = lds_byte(wc * 32 + fr, fq * 8);
#define PG8_SA(b, h) (((b) * 2 + (h)) * HTB)
#define PG8_SB(b, h) ((4 + (b) * 2 + (h)) * HTB)
#define PG8_STAGE(bufoff, gbase, voff) do { _Pragma("unroll") for (int _i = 0; _i < 2; ++_i) \
        __builtin_amdgcn_global_load_lds((const unsigned*)((const char*)(gbase) + (voff)[_i]), (PG8_LAS unsigned*)(lds + (bufoff) + ldsw + _i * 8192), 16, 0, 0); } while (0)
#define PG8_LDA(dst, b, h) do { _Pragma("unroll") for (int m = 0; m < 4; ++m) _Pragma("unroll") for (int k = 0; k < 2; ++k) dst[m][k] = *(const PG8_LAS bf16x8*)(lds + PG8_SA(b, h) + aoff + m * 2048 + k * 1024); } while (0)
#define PG8_LDB(dst, b, h) do { _Pragma("unroll") for (int n = 0; n < 2; ++n) _Pragma("unroll") for (int k = 0; k < 2; ++k) dst[n][k] = *(const PG8_LAS bf16x8*)(lds + PG8_SB(b, h) + boff + n * 2048 + k * 1024); } while (0)
#define PG8_MMA(ai, bj, At, Bt) do { __builtin_amdgcn_s_setprio(1); _Pragma("unroll") for (int m = 0; m < 4; ++m) _Pragma("unroll") for (int n = 0; n < 2; ++n) _Pragma("unroll") for (int k = 0; k < 2; ++k) \
        acc[ai][bj][m][n] = __builtin_amdgcn_mfma_f32_16x16x32_bf16(Bt[n][k], At[m][k], acc[ai][bj][m][n], 0, 0, 0); __builtin_amdgcn_s_setprio(0); } while (0)
#define PG8_WAIT_V(n) asm volatile("s_waitcnt vmcnt(" #n ")" ::: "memory")
#define PG8_WAIT_L(n) asm volatile("s_waitcnt lgkmcnt(" #n ")" ::: "memory")
#define PG8_BAR __builtin_amdgcn_s_barrier()
#define PG8_SCHED __builtin_amdgcn_sched_barrier(0)
    Unit cur, nxt; int ui = 0;
    if (!S.next(0, cur)) return;
    f32x4 acc[2][2][4][2];
#pragma unroll
    for (int a = 0; a < 2; ++a)
#pragma unroll
        for (int b = 0; b < 2; ++b)
#pragma unroll
            for (int m = 0; m < 4; ++m)
#pragma unroll
                for (int n = 0; n < 2; ++n) acc[a][b][m][n] = (f32x4){0.f, 0.f, 0.f, 0.f};
    bf16x8 At[4][2], B0[2][2], B1[2][2];
    const char* cA = (const char*)g.A + (size_t)cur.pm * tstepA; const char* cB = (const char*)g.Bt + (size_t)cur.pn * tstepB;
    S.a_ready(cur);
    if constexpr (SP2) {
        PG8_STAGE(PG8_SB(0, 0), cB, voffB); PG8_STAGE(PG8_SB(0, 1), cB + hstepB, voffB); PG8_STAGE(PG8_SA(0, 0), cA, voffA); PG8_STAGE(PG8_SA(0, 1), cA + hstepA, voffA);
        if (wr == 1) PG8_BAR;
        PG8_WAIT_V(2); PG8_BAR;
        PG8_STAGE(PG8_SB(1, 0), cB + kstep, voffB); PG8_STAGE(PG8_SA(1, 0), cA + kstep, voffA); PG8_STAGE(PG8_SB(1, 1), cB + hstepB + kstep, voffB);
        PG8_WAIT_V(6); PG8_BAR;
    } else {
        PG8_STAGE(PG8_SB(0, 0), cB, voffB); PG8_STAGE(PG8_SA(0, 0), cA, voffA); PG8_STAGE(PG8_SB(0, 1), cB + hstepB, voffB); PG8_STAGE(PG8_SA(0, 1), cA + hstepA, voffA);
        if (wr == 1) PG8_BAR;
        PG8_WAIT_V(4); PG8_BAR;
        PG8_STAGE(PG8_SB(1, 0), cB + kstep, voffB); PG8_STAGE(PG8_SA(1, 0), cA + kstep, voffA); PG8_STAGE(PG8_SB(1, 1), cB + hstepB + kstep, voffB);
        PG8_WAIT_V(6); PG8_BAR;
    }
    for (;;) {
        const bool has_next = S.next(ui + 1, nxt);
        const char* nA = has_next ? (const char*)g.A + (size_t)nxt.pm * tstepA : cA; const char* nB = has_next ? (const char*)g.Bt + (size_t)nxt.pn * tstepB : cB;
        for (int t = 0; t < nt; t += 2) {
            const bool last = (t == nt - 2);
            const char* a1 = cA + (size_t)(t + 1) * kstep;
            const char* a2 = last ? nA : cA + (size_t)(t + 2) * kstep; const char* b2 = last ? nB : cB + (size_t)(t + 2) * kstep;
            const char* a3 = a2 + kstep; const char* b3 = b2 + kstep;
            if (last && has_next) S.a_ready(nxt);
            if constexpr (SP2) {
            PG8_LDB(B0, 0, 0); PG8_LDB(B1, 0, 1); PG8_SCHED; PG8_LDA(At, 0, 0); PG8_STAGE(PG8_SA(1, 1), a1 + hstepA, voffA);
            PG8_WAIT_V(8); PG8_WAIT_L(0); PG8_BAR; PG8_MMA(0, 0, At, B0); PG8_MMA(0, 1, At, B1); PG8_BAR; PG8_SCHED;
            PG8_LDA(At, 0, 1); PG8_STAGE(PG8_SB(0, 0), b2, voffB); PG8_STAGE(PG8_SB(0, 1), b2 + hstepB, voffB); PG8_STAGE(PG8_SA(0, 0), a2, voffA);
            PG8_WAIT_V(8); PG8_WAIT_L(0); PG8_BAR; PG8_MMA(1, 0, At, B0); PG8_MMA(1, 1, At, B1); PG8_BAR; PG8_SCHED;
            PG8_LDB(B0, 1, 0); PG8_LDB(B1, 1, 1); PG8_SCHED; PG8_LDA(At, 1, 0); PG8_STAGE(PG8_SA(0, 1), a2 + hstepA, voffA);
            PG8_WAIT_V(8); PG8_WAIT_L(0); PG8_BAR; PG8_MMA(0, 0, At, B0); PG8_MMA(0, 1, At, B1); PG8_BAR; PG8_SCHED;
            PG8_LDA(At, 1, 1); PG8_STAGE(PG8_SB(1, 0), b3, voffB); PG8_STAGE(PG8_SB(1, 1), b3 + hstepB, voffB); PG8_STAGE(PG8_SA(1, 0), a3, voffA);
            PG8_WAIT_V(8); PG8_WAIT_L(0); PG8_BAR; PG8_MMA(1, 0, At, B0); PG8_MMA(1, 1, At, B1); PG8_BAR; PG8_SCHED;
            } else {
            PG8_LDB(B0, 0, 0); PG8_SCHED; PG8_LDA(At, 0, 0); PG8_STAGE(PG8_SA(1, 1), a1 + hstepA, voffA);
            PG8_WAIT_L(8); PG8_BAR; PG8_WAIT_L(0); PG8_MMA(0, 0, At, B0); PG8_BAR; PG8_SCHED;
            PG8_LDB(B1, 0, 1); PG8_STAGE(PG8_SB(0, 0), b2, voffB);
            PG8_BAR; PG8_WAIT_L(0); PG8_MMA(0, 1, At, B1); PG8_BAR;
            PG8_LDA(At, 0, 1); PG8_STAGE(PG8_SA(0, 0), a2, voffA);
            PG8_BAR; PG8_WAIT_L(0); PG8_MMA(1, 0, At, B0); PG8_BAR; PG8_SCHED;
            PG8_STAGE(PG8_SB(0, 1), b2 + hstepB, voffB);
            PG8_WAIT_V(6); PG8_BAR; PG8_MMA(1, 1, At, B1); PG8_BAR;
            PG8_LDB(B0, 1, 0); PG8_SCHED; PG8_LDA(At, 1, 0); PG8_STAGE(PG8_SA(0, 1), a2 + hstepA, voffA);
            PG8_WAIT_L(8); PG8_BAR; PG8_WAIT_L(0); PG8_MMA(0, 0, At, B0); PG8_BAR; PG8_SCHED;
            PG8_LDB(B1, 1, 1); PG8_STAGE(PG8_SB(1, 0), b3, voffB);
            PG8_BAR; PG8_WAIT_L(0); PG8_MMA(0, 1, At, B1); PG8_BAR;
            PG8_LDA(At, 1, 1); PG8_STAGE(PG8_SA(1, 0), a3, voffA);
            PG8_BAR; PG8_WAIT_L(0); PG8_MMA(1, 0, At, B0); PG8_BAR; PG8_SCHED;
            PG8_STAGE(PG8_SB(1, 1), b3 + hstepB, voffB);
            PG8_WAIT_V(6); PG8_BAR; PG8_MMA(1, 1, At, B1); PG8_BAR;
            }
        }
        if constexpr (ALIGN_EPI) { if (wr == 0) PG8_BAR; }
        if constexpr (!Epi::AFTER_DRAIN) { E(acc, cur, wr, wc, fr, fq); S.done(cur); }
        if (!has_next) break;
#pragma unroll
        for (int a = 0; a < 2; ++a)
#pragma unroll
            for (int b = 0; b < 2; ++b)
#pragma unroll
                for (int m = 0; m < 4; ++m)
#pragma unroll
                    for (int n = 0; n < 2; ++n) acc[a][b][m][n] = (f32x4){0.f, 0.f, 0.f, 0.f};
        cur = nxt; cA = nA; cB = nB; ++ui;
        if constexpr (ALIGN_EPI) { if (wr == 1) PG8_BAR; }
    }
    PG8_WAIT_V(0);
    if constexpr (!ALIGN_EPI) { if (wr == 0) PG8_BAR; }
    PG8_BAR;
    if constexpr (Epi::AFTER_DRAIN) { E.fused(acc, cur, wr, wc, fr, fq, lds, wid, lane); S.done(cur); }
#undef PG8_SA
#undef PG8_SB
#undef PG8_STAGE
#undef PG8_LDA
#undef PG8_LDB
#undef PG8_MMA
#undef PG8_WAIT_V
#undef PG8_WAIT_L
#undef PG8_BAR
#undef PG8_SCHED
}
}


typedef unsigned short bf16;
typedef unsigned u32x4 __attribute__((ext_vector_type(4)));
typedef float f32x4 __attribute__((ext_vector_type(4)));
#define LAS __attribute__((address_space(3)))
constexpr int DM = 1024, MP = 32768, MS = 512, MT = MP + MS;
constexpr int TP = 4096, TS = 16, PAST = 2048, KS = PAST + TS;
constexpr int NPROJ = 6144, INW = 6152;
constexpr int C_FQ = 0, C_FK = 512, C_FV = 1024, C_FZ = 1536, C_DQ = 2048, C_DK = 2560, C_DV = 3072, C_DZ = 3584, C_GA = 4096, C_GB = 5120;
constexpr size_t O_YP = 0, O_YS = 33554432, O_FKP = 34078720, O_FVP = 50855936, O_FLP = 67633152, O_DKP = 67895296, O_DVP = 84672512,
                 O_FKS = 101449728, O_FVS = 101711872, O_FLS = 101974016, O_DKS = 101978112, O_DVS = 102240256, O_END = 102502400;
constexpr size_t MiB = 1u << 20;
constexpr size_t WS_CTL = 0, WS_WIN = 2 * MiB, WS_WF = 14 * MiB, WS_WD = 15 * MiB, WS_WO = 16 * MiB, WS_CUMP = 18 * MiB, WS_CUMS = 19 * MiB,
                 WS_XN = 24 * MiB  , WS_P = 90 * MiB  , WS_Y = 480 * MiB  , WS_MG = 546 * MiB  , WS_END = 612 * MiB;
constexpr float LOG2E = 1.4426950408889634f, C2 = 0.125f * 1.4426950408889634f, NORM_EPS = 1e-6f;
constexpr int LDS_BYTES = 147456;
constexpr int NPHASE = 6;

struct Params { const float* in[20]; float* out; unsigned char* ws; int ph_lo, ph_hi; };

__device__ __forceinline__ unsigned f2bf(float f) { unsigned u = __builtin_bit_cast(unsigned, f); return (u + 0x7fffu + ((u >> 16) & 1u)) >> 16; }
__device__ __forceinline__ unsigned pk2(float lo, float hi) { return f2bf(lo) | (f2bf(hi) << 16); }
__device__ __forceinline__ float bf2f(unsigned short b) { return __uint_as_float((unsigned)b << 16); }
__device__ __forceinline__ float bflo(unsigned w) { return __uint_as_float(w << 16); }
__device__ __forceinline__ float bfhi(unsigned w) { return __uint_as_float(w & 0xffff0000u); }
__device__ __forceinline__ float wave_sum(float v) {
#pragma unroll
    for (int o = 1; o < 64; o <<= 1) v += __shfl_xor(v, o);
    return v;
}
__device__ __forceinline__ float wave_max(float v) {
#pragma unroll
    for (int o = 1; o < 64; o <<= 1) v = fmaxf(v, __shfl_xor(v, o));
    return v;
}
__device__ __forceinline__ float sigmoidf_(float z) { return __builtin_amdgcn_rcpf(1.f + __builtin_amdgcn_exp2f(-z * LOG2E)); }

namespace pg8 {
struct EpiProj {
    static constexpr bool PERM = true, AFTER_DRAIN = false;
    bf16_t* P; float* out;
    __device__ __forceinline__ void operator()(const f32x4 (&acc)[2][2][4][2], const Unit& u, int wr, int wc, int fr, int fq) const {
        const int colt = u.pn * BM, seg = colt >> 9;
        const bool samp = u.pm >= (MP / BM);
        int op; float* fo = nullptr;
        if (seg == 0 || seg == 4) op = 0; else if (seg == 3 || seg == 7) op = 2; else if (seg >= 8) op = 3;
        else { op = 1; const size_t ob = seg == 1 ? (samp ? O_FKS : O_FKP) : seg == 2 ? (samp ? O_FVS : O_FVP) : seg == 5 ? (samp ? O_DKS : O_DKP) : (samp ? O_DVS : O_DVP); fo = out + ob; }
        const int row0 = u.pm * BM + wr * 64 + fr, col0 = colt + wc * 32 + 8 * fq, scol0 = col0 - (seg << 9);
#pragma unroll
        for (int ai = 0; ai < 2; ++ai)
#pragma unroll
            for (int m = 0; m < 4; ++m) { const int r = row0 + ai * HALF + m * 16; bf16_t* rowp = P + (size_t)r * NPROJ + col0; const int rr = samp ? r - MP : r;
#pragma unroll
                for (int bj = 0; bj < 2; ++bj) { f32x4 v0 = acc[ai][bj][m][0], v1 = acc[ai][bj][m][1];
                    if (op == 1) { float* fp = fo + (size_t)rr * 512 + scol0 + bj * HALF; *(f32x4*)fp = v0; *(f32x4*)(fp + 4) = v1; }
                    else if (op == 0) { v0 = v0 * C2; v1 = v1 * C2; }
                    else {
#pragma unroll
                        for (int e = 0; e < 4; ++e) { const float s0 = sigmoidf_(v0[e]), s1 = sigmoidf_(v1[e]); v0[e] = op == 2 ? v0[e] * s0 : s0; v1[e] = op == 2 ? v1[e] * s1 : s1; } }
                    u32x4 w; w.x = pk2(v0[0], v0[1]); w.y = pk2(v0[2], v0[3]); w.z = pk2(v1[0], v1[1]); w.w = pk2(v1[2], v1[3]);
                    *(u32x4*)(rowp + bj * HALF) = w; } }
    }
};
struct EpiT {
    static constexpr bool PERM = true, AFTER_DRAIN = false;
    const bf16_t* P; bf16_t* T;
    __device__ __forceinline__ void operator()(const f32x4 (&acc)[2][2][4][2], const Unit& u, int wr, int wc, int fr, int fq) const {
        const int row0 = u.pm * BM + wr * 64 + fr, col0 = u.pn * BM + wc * 32 + 8 * fq;
#pragma unroll
        for (int ai = 0; ai < 2; ++ai)
#pragma unroll
            for (int m = 0; m < 4; ++m) { const int r = row0 + ai * HALF + m * 16;
#pragma unroll
                for (int bj = 0; bj < 2; ++bj) { const int c = col0 + bj * HALF; const f32x4 v0 = acc[ai][bj][m][0], v1 = acc[ai][bj][m][1];
                    const u32x4 g = *(const u32x4*)(P + (size_t)r * NPROJ + C_GA + c);
                    u32x4 w; w.x = pk2(v0[0] * bflo(g.x), v0[1] * bfhi(g.x)); w.y = pk2(v0[2] * bflo(g.y), v0[3] * bfhi(g.y)); w.z = pk2(v1[0] * bflo(g.z), v1[1] * bfhi(g.z)); w.w = pk2(v1[2] * bflo(g.w), v1[3] * bfhi(g.w));
                    *(u32x4*)(T + (size_t)r * DM + c) = w; } }
    }
};
struct EpiMG {
    static constexpr bool PERM = true, AFTER_DRAIN = false;
    const bf16_t* P; const bf16_t* T; bf16_t* MG;
    __device__ __forceinline__ void operator()(const f32x4 (&acc)[2][2][4][2], const Unit& u, int wr, int wc, int fr, int fq) const {
        const int row0 = u.pm * BM + wr * 64 + fr, col0 = u.pn * BM + wc * 32 + 8 * fq;
#pragma unroll
        for (int ai = 0; ai < 2; ++ai)
#pragma unroll
            for (int m = 0; m < 4; ++m) { const int r = row0 + ai * HALF + m * 16;
#pragma unroll
                for (int bj = 0; bj < 2; ++bj) { const int c = col0 + bj * HALF; const f32x4 v0 = acc[ai][bj][m][0], v1 = acc[ai][bj][m][1];
                    const u32x4 g = *(const u32x4*)(P + (size_t)r * NPROJ + C_GB + c); const u32x4 t = *(const u32x4*)(T + (size_t)r * DM + c);
                    u32x4 w; w.x = pk2(bflo(t.x) + v0[0] * bflo(g.x), bfhi(t.x) + v0[1] * bfhi(g.x)); w.y = pk2(bflo(t.y) + v0[2] * bflo(g.y), bfhi(t.y) + v0[3] * bfhi(g.y));
                    w.z = pk2(bflo(t.z) + v1[0] * bflo(g.z), bfhi(t.z) + v1[1] * bfhi(g.z)); w.w = pk2(bflo(t.w) + v1[2] * bflo(g.w), bfhi(t.w) + v1[3] * bfhi(g.w));
                    *(u32x4*)(MG + (size_t)r * DM + c) = w; } }
    }
};
struct EpiOut {
    static constexpr bool PERM = true, AFTER_DRAIN = false;
    const float* xp; const float* xs; float* out;
    __device__ __forceinline__ void operator()(const f32x4 (&acc)[2][2][4][2], const Unit& u, int wr, int wc, int fr, int fq) const {
        const int row0 = u.pm * BM + wr * 64 + fr, col0 = u.pn * BM + wc * 32 + 8 * fq;
        const bool samp = u.pm >= (MP / BM);
#pragma unroll
        for (int ai = 0; ai < 2; ++ai)
#pragma unroll
            for (int m = 0; m < 4; ++m) { const int r = row0 + ai * HALF + m * 16; const float* xr = samp ? xs + (size_t)(r - MP) * DM : xp + (size_t)r * DM;
#pragma unroll
                for (int bj = 0; bj < 2; ++bj) { const int c = col0 + bj * HALF;
                    const f32x4 x0 = *(const f32x4*)(xr + c), x1 = *(const f32x4*)(xr + c + 4);
                    *(f32x4*)(out + (size_t)r * DM + c) = x0 + acc[ai][bj][m][0]; *(f32x4*)(out + (size_t)r * DM + c + 4) = x1 + acc[ai][bj][m][1]; } }
    }
};
}

struct Frame {
    LAS unsigned char* lds; int tid, lane, wave, gw, ngw;
    const float* const* in; float* out; unsigned char* ws;
};

__device__ __forceinline__ void transpose_item(const float* W, int ldw, int c0, int k0, bf16* WT, int ldt, int n0, LAS float* scr, int lane) {
#pragma unroll 8
    for (int i = 0; i < 32; ++i) { const int kk = 2 * i + (lane >> 5); scr[kk * 33 + (lane & 31)] = W[(size_t)(k0 + kk) * ldw + c0 + (lane & 31)]; }
    asm volatile("s_waitcnt lgkmcnt(0)" ::: "memory");
    const int c = lane & 7;
#pragma unroll
    for (int j = 0; j < 4; ++j) { const int n = (lane >> 3) + 8 * j; const LAS float* s = scr + (8 * c) * 33 + n;
        u32x4 o; o.x = pk2(s[0 * 33], s[1 * 33]); o.y = pk2(s[2 * 33], s[3 * 33]); o.z = pk2(s[4 * 33], s[5 * 33]); o.w = pk2(s[6 * 33], s[7 * 33]);
        *(u32x4*)(WT + (size_t)(n0 + n) * ldt + k0 + 8 * c) = o; }
    asm volatile("s_waitcnt lgkmcnt(0)" ::: "memory");
}
__device__ __forceinline__ float log_sigmoid_f(float z) { return fminf(z, 0.f) - log1pf(expf(-fabsf(z))); }

__device__ __forceinline__ void phase0(const Frame& F) {
    const float* w_in = F.in[8]; const float* wuf = F.in[15]; const float* wud = F.in[16]; const float* wo = F.in[17];
    bf16* WIN = (bf16*)(F.ws + WS_WIN); bf16* WF = (bf16*)(F.ws + WS_WF); bf16* WD = (bf16*)(F.ws + WS_WD); bf16* WO = (bf16*)(F.ws + WS_WO);
    LAS float* scr = (LAS float*)(F.lds + F.wave * 16384);
    constexpr int I_IN = 16 * 192, I_UP = 8 * 32, I_O = 16 * 32, NITEMS = I_IN + 2 * I_UP + I_O;
    for (int it = F.gw; it < NITEMS; it += F.ngw) {
        int r = it;
        if (r < I_IN) { const int kb = r / 192, nb = r % 192, n0 = nb * 32; transpose_item(w_in, INW, n0 + (n0 >= 2048 ? 8 : 0), kb * 64, WIN, DM, n0, scr, F.lane); continue; } r -= I_IN;
        if (r < I_UP) { const int kb = r / 32, nb = r % 32; transpose_item(wuf, DM, nb * 32, kb * 64, WF, 512, nb * 32, scr, F.lane); continue; } r -= I_UP;
        if (r < I_UP) { const int kb = r / 32, nb = r % 32; transpose_item(wud, DM, nb * 32, kb * 64, WD, 512, nb * 32, scr, F.lane); continue; } r -= I_UP;
        { const int kb = r / 32, nb = r % 32; transpose_item(wo, DM, nb * 32, kb * 64, WO, DM, nb * 32, scr, F.lane); }
    }
    __syncthreads();
    LAS float* wgT = (LAS float*)F.lds; const float* gin = F.in[7];
    for (int i = F.tid; i < 8 * DM; i += 512) { const int j = i >> 10, k = i & 1023; wgT[i] = gin[k] * w_in[(size_t)k * INW + 2048 + j]; }
    __syncthreads();
    const float* xp = F.in[0]; const float* xs = F.in[1]; const float* bfg = F.in[9];
    bf16* XN = (bf16*)(F.ws + WS_XN);
    for (int m = F.gw; m < MT; m += F.ngw) {
        const float* xrow = m < MP ? xp + (size_t)m * DM : xs + (size_t)(m - MP) * DM;
        f32x4 v[4]; float ss = 0.f;
#pragma unroll
        for (int j = 0; j < 4; ++j) { v[j] = *(const f32x4*)(xrow + 4 * (F.lane + 64 * j)); ss += (v[j][0] * v[j][0] + v[j][1] * v[j][1]) + (v[j][2] * v[j][2] + v[j][3] * v[j][3]); }
        const float rstd = 1.0f / sqrtf(wave_sum(ss) * (1.f / DM) + NORM_EPS);
        float fl[8];
#pragma unroll
        for (int jj = 0; jj < 8; ++jj) { float a = 0.f;
#pragma unroll
            for (int j = 0; j < 4; ++j) { const f32x4 w = *(const LAS f32x4*)(wgT + jj * DM + 4 * (F.lane + 64 * j)); a += (v[j][0] * w[0] + v[j][1] * w[1]) + (v[j][2] * w[2] + v[j][3] * w[3]); }
            fl[jj] = wave_sum(a) * rstd; }
        float mine = fl[0];
#pragma unroll
        for (int jj = 1; jj < 8; ++jj) mine = (F.lane == jj) ? fl[jj] : mine;
        if (F.lane < 8) { const float lf = log_sigmoid_f(mine + bfg[F.lane]);
            if (m < MP) F.out[O_FLP + (size_t)m * 8 + F.lane] = lf; else F.out[O_FLS + (size_t)(m - MP) * 8 + F.lane] = lf; }
#pragma unroll
        for (int j = 0; j < 4; ++j) { const f32x4 g = *(const f32x4*)(gin + 4 * (F.lane + 64 * j));
            const unsigned lo = pk2(v[j][0] * rstd * g[0], v[j][1] * rstd * g[1]), hi = pk2(v[j][2] * rstd * g[2], v[j][3] * rstd * g[3]);
            *(unsigned long long*)(XN + (size_t)m * DM + 4 * (F.lane + 64 * j)) = (unsigned long long)lo | ((unsigned long long)hi << 32); }
    }
}

__device__ __forceinline__ double wave_excl_scan(double s, int lane) {
    double inc = s;
#pragma unroll
    for (int o = 1; o < 64; o <<= 1) { const double t = __shfl_up(inc, o); if (lane >= o) inc += t; }
    return inc - s;
}
__device__ __forceinline__ void scan_phase(const Frame& F) {
    float* cumP = (float*)(F.ws + WS_CUMP); float* cumS = (float*)(F.ws + WS_CUMS);
    if (F.gw < 64) {
        const int b = F.gw >> 3, h = F.gw & 7; const float* src = F.out + O_FLP + (size_t)b * TP * 8 + h;
        double s = 0.0;
        for (int i = 0; i < 64; ++i) s += (double)src[(size_t)(F.lane * 64 + i) * 8];
        double run = wave_excl_scan(s, F.lane);
        float* dst = cumP + (size_t)(b * 8 + h) * TP + F.lane * 64;
        for (int i = 0; i < 64; ++i) { run += (double)src[(size_t)(F.lane * 64 + i) * 8]; dst[i] = (float)run; }
    } else if (F.gw < 64 + 256) {
        const int g = F.gw - 64, b = g >> 3, h = g & 7; const float* past = F.in[4] + (size_t)b * PAST * 8 + h; const float* nw = F.out + O_FLS + (size_t)b * TS * 8 + h;
        double s = 0.0;
        for (int i = 0; i < 33; ++i) { const int j = F.lane * 33 + i; if (j < KS) s += (double)(j < PAST ? past[(size_t)j * 8] : nw[(size_t)(j - PAST) * 8]); }
        double run = wave_excl_scan(s, F.lane);
        float* dst = cumS + (size_t)(b * 8 + h) * KS;
        for (int i = 0; i < 33; ++i) { const int j = F.lane * 33 + i; if (j < KS) { run += (double)(j < PAST ? past[(size_t)j * 8] : nw[(size_t)(j - PAST) * 8]); dst[j] = (float)run; } }
    }
}

__device__ __forceinline__ int t5_bucket(int rel) {
    const int n = rel < 0 ? -rel : rel; int b;
    if (n < 8) b = n; else if (n < 12) b = 8; else if (n < 16) b = 9; else if (n < 23) b = 10; else if (n < 32) b = 11; else if (n < 46) b = 12; else if (n < 64) b = 13; else if (n < 91) b = 14; else b = 15;
    return (rel > 0 ? 16 : 0) + b;
}
struct QVec { float q[64]; };
__device__ __forceinline__ void load_q(QVec& Q, const bf16* p) {
#pragma unroll
    for (int c = 0; c < 8; ++c) { const u32x4 w = *(const u32x4*)(p + 8 * c);
        Q.q[8 * c + 0] = bflo(w.x); Q.q[8 * c + 1] = bfhi(w.x); Q.q[8 * c + 2] = bflo(w.y); Q.q[8 * c + 3] = bfhi(w.y); Q.q[8 * c + 4] = bflo(w.z); Q.q[8 * c + 5] = bfhi(w.z); Q.q[8 * c + 6] = bflo(w.w); Q.q[8 * c + 7] = bfhi(w.w); }
}
__device__ __forceinline__ float dot_bf16(const QVec& Q, const bf16* p) {
    float s = 0.f;
#pragma unroll
    for (int c = 0; c < 8; ++c) { const u32x4 w = *(const u32x4*)(p + 8 * c);
        s += Q.q[8 * c + 0] * bflo(w.x); s += Q.q[8 * c + 1] * bfhi(w.x); s += Q.q[8 * c + 2] * bflo(w.y); s += Q.q[8 * c + 3] * bfhi(w.y);
        s += Q.q[8 * c + 4] * bflo(w.z); s += Q.q[8 * c + 5] * bfhi(w.z); s += Q.q[8 * c + 6] * bflo(w.w); s += Q.q[8 * c + 7] * bfhi(w.w); }
    return s;
}
__device__ __forceinline__ float dot_f32(const QVec& Q, const float* p) {
    float s = 0.f;
#pragma unroll
    for (int c = 0; c < 16; ++c) { const f32x4 w = *(const f32x4*)(p + 4 * c); s += Q.q[4 * c] * w[0]; s += Q.q[4 * c + 1] * w[1]; s += Q.q[4 * c + 2] * w[2]; s += Q.q[4 * c + 3] * w[3]; }
    return s;
}
template <int NE, class Score, class Val>
__device__ __forceinline__ void naive_attn(int nkeys, Score score, Val val, float (&o)[NE], int lane) {
    float m = -INFINITY, l = 0.f;
#pragma unroll
    for (int e = 0; e < NE; ++e) o[e] = 0.f;
    for (int j0 = 0; j0 < nkeys; j0 += 64) {
        const int j = j0 + lane; const bool valid = j < nkeys;
        float s = -INFINITY; if (valid) s = score(j);
        const float mn = fmaxf(m, wave_max(s));
        const float alpha = exp2f(m - mn), pj = valid ? exp2f(s - mn) : 0.f;
        l = l * alpha + wave_sum(pj);
#pragma unroll
        for (int e = 0; e < NE; ++e) o[e] *= alpha;
        const int nj = (nkeys - j0) < 64 ? (nkeys - j0) : 64;
        for (int jj = 0; jj < nj; ++jj) { const float pb = __shfl(pj, jj);
#pragma unroll
            for (int e = 0; e < NE; ++e) o[e] += pb * val(j0 + jj, e); }
        m = mn;
    }
    const float il = 1.f / l;
#pragma unroll
    for (int e = 0; e < NE; ++e) o[e] *= il;
}
__device__ __forceinline__ void attn_naive_phase(const Frame& F) {
    const bf16* P = (const bf16*)(F.ws + WS_P); bf16* Y = (bf16*)(F.ws + WS_Y);
    const float* cumP = (const float*)(F.ws + WS_CUMP); const float* cumS = (const float*)(F.ws + WS_CUMS);
    const float* cfk = F.in[2]; const float* cfv = F.in[3]; const float* cdk = F.in[5]; const float* cdv = F.in[6];
    const float* tbl = F.in[18]; const float* sg = F.in[14];
    const int lane = F.lane;
    const float lam = expf(wave_sum(F.in[10][lane] * F.in[11][lane])) - expf(wave_sum(F.in[12][lane] * F.in[13][lane])) + 0.2f;
    for (int it = F.gw; it < MP * 8; it += F.ngw) {
        const int h = it & 7, m = it >> 3, b = m >> 12, t = m & 4095;
        const bf16* Pm = P + (size_t)m * NPROJ; const bf16* Pb = P + (size_t)(b * TP) * NPROJ;
        QVec Q; load_q(Q, Pm + C_FQ + h * 64);
        const float* cum = cumP + (size_t)(b * 8 + h) * TP; const float cq = cum[t];
        float o[1];
        naive_attn<1>(t + 1, [&](int j) { return dot_bf16(Q, Pb + (size_t)j * NPROJ + C_FK + h * 64) + (cq - cum[j]) * LOG2E; },
                      [&](int j, int e) { return bf2f(Pb[(size_t)j * NPROJ + C_FV + h * 64 + lane]); }, o, lane);
        Y[(size_t)m * DM + h * 64 + lane] = (bf16)f2bf(o[0] * bf2f(Pm[C_FZ + h * 64 + lane]));
    }
    for (int it = F.gw; it < MS * 8; it += F.ngw) {
        const int h = it & 7, ms = it >> 3, b = ms >> 4, t = ms & 15, m = MP + ms;
        const bf16* Pm = P + (size_t)m * NPROJ; const bf16* Pn = P + (size_t)(MP + b * TS) * NPROJ;
        QVec Q; load_q(Q, Pm + C_FQ + h * 64);
        const float* cum = cumS + (size_t)(b * 8 + h) * KS; const float cq = cum[PAST + t];
        const float* kb = cfk + ((size_t)b * PAST * 8 + h) * 64; const float* vb = cfv + ((size_t)b * PAST * 8 + h) * 64;
        float o[1];
        naive_attn<1>(PAST + t + 1, [&](int j) { return (j < PAST ? dot_f32(Q, kb + (size_t)j * 512) : dot_bf16(Q, Pn + (size_t)(j - PAST) * NPROJ + C_FK + h * 64)) + (cq - cum[j]) * LOG2E; },
                      [&](int j, int e) { return j < PAST ? vb[(size_t)j * 512 + lane] : bf2f(Pn[(size_t)(j - PAST) * NPROJ + C_FV + h * 64 + lane]); }, o, lane);
        Y[(size_t)m * DM + h * 64 + lane] = (bf16)f2bf(o[0] * bf2f(Pm[C_FZ + h * 64 + lane]));
    }
    for (int it = F.gw; it < (MP + MS) * 4; it += F.ngw) {
        const int h = it & 3, m = it >> 2; const bool samp = m >= MP;
        const int b = samp ? (m - MP) >> 4 : m >> 12, t = samp ? (m - MP) & 15 : m & 4095;
        const bf16* Pm = P + (size_t)m * NPROJ; const bf16* Pb = samp ? P + (size_t)(MP + b * TS) * NPROJ : P + (size_t)(b * TP) * NPROJ;
        const int qpos = samp ? PAST + t : t, nkeys = samp ? KS : ((t >> 6) + 1) * 64;
        const float* kb = cdk + ((size_t)b * PAST * 4 + h) * 128; const float* vb = cdv + ((size_t)b * PAST * 4 + h) * 128;
        float oo[2][2];
#pragma unroll
        for (int mm = 0; mm < 2; ++mm) {
            QVec Q; load_q(Q, Pm + C_DQ + h * 128 + mm * 64);
            if (samp) naive_attn<2>(nkeys, [&](int j) { return (j < PAST ? dot_f32(Q, kb + (size_t)j * 512 + mm * 64) : dot_bf16(Q, Pb + (size_t)(j - PAST) * NPROJ + C_DK + h * 128 + mm * 64)) + tbl[t5_bucket(j - qpos) * 4 + h] * LOG2E; },
                                    [&](int j, int e) { return j < PAST ? vb[(size_t)j * 512 + e * 64 + lane] : bf2f(Pb[(size_t)(j - PAST) * NPROJ + C_DV + h * 128 + e * 64 + lane]); }, oo[mm], lane);
            else naive_attn<2>(nkeys, [&](int j) { return dot_bf16(Q, Pb + (size_t)j * NPROJ + C_DK + h * 128 + mm * 64) + tbl[t5_bucket(j - qpos) * 4 + h] * LOG2E; },
                               [&](int j, int e) { return bf2f(Pb[(size_t)j * NPROJ + C_DV + h * 128 + e * 64 + lane]); }, oo[mm], lane);
        }
        const float d0 = oo[0][0] - lam * oo[1][0], d1 = oo[0][1] - lam * oo[1][1];
        const float r = 1.0f / sqrtf(wave_sum(d0 * d0 + d1 * d1) * (1.f / 128.f) + NORM_EPS);
        Y[(size_t)m * DM + 512 + h * 128 + lane] = (bf16)f2bf(d0 * r * sg[lane] * 0.8f * bf2f(Pm[C_DZ + h * 128 + lane]));
        Y[(size_t)m * DM + 512 + h * 128 + 64 + lane] = (bf16)f2bf(d1 * r * sg[64 + lane] * 0.8f * bf2f(Pm[C_DZ + h * 128 + 64 + lane]));
    }
}

__device__ __forceinline__ void final_norm_phase(const Frame& F) {
    const float* gf = F.in[19];
    for (int m = F.gw; m < MT; m += F.ngw) {
        float* row = F.out + (size_t)m * DM; f32x4 v[4]; float ss = 0.f;
#pragma unroll
        for (int j = 0; j < 4; ++j) { v[j] = *(const f32x4*)(row + 4 * (F.lane + 64 * j)); ss += (v[j][0] * v[j][0] + v[j][1] * v[j][1]) + (v[j][2] * v[j][2] + v[j][3] * v[j][3]); }
        const float rstd = 1.0f / sqrtf(wave_sum(ss) * (1.f / DM) + NORM_EPS);
#pragma unroll
        for (int j = 0; j < 4; ++j) { const f32x4 g = *(const f32x4*)(gf + 4 * (F.lane + 64 * j)); *(f32x4*)(row + 4 * (F.lane + 64 * j)) = v[j] * rstd * g; }
    }
}

#ifndef MK_MULTI
#define MK_MULTI 0
#endif
__global__ void __launch_bounds__(512, 2) fwd_kernel(Params p) {
    extern __shared__ __attribute__((aligned(16))) unsigned char lds_raw[];
    cg::grid_group grid = cg::this_grid();
    Frame F; F.lds = (LAS unsigned char*)lds_raw; F.tid = threadIdx.x; F.lane = F.tid & 63; F.wave = __builtin_amdgcn_readfirstlane(F.tid >> 6);
    F.gw = blockIdx.x * 8 + F.wave; F.ngw = gridDim.x * 8; F.in = p.in; F.out = p.out; F.ws = p.ws;
    const int lo = p.ph_lo, hi = p.ph_hi;
#define IN(k) (lo <= (k) && (k) < hi)
#define SEAM(k) do { if (IN(k) && IN((k) + 1)) grid.sync(); } while (0)
    bf16* XN = (bf16*)(p.ws + WS_XN); bf16* Pb = (bf16*)(p.ws + WS_P); bf16* Y = (bf16*)(p.ws + WS_Y); bf16* T = (bf16*)(p.ws + WS_XN); bf16* MG = (bf16*)(p.ws + WS_MG);
    if (IN(0)) phase0(F);
    SEAM(0);
    if (IN(1)) {
        scan_phase(F);
        pg8::Gemm g{XN, (const bf16*)(p.ws + WS_WIN), MT, NPROJ, DM, DM, DM}; pg8::StaticOrder S; S.init(MT, NPROJ, (int)gridDim.x, (int)blockIdx.x);
        pg8::EpiProj E{Pb, p.out};
        pg8::gemm_phase<pg8::EpiProj, pg8::StaticOrder, true, true>(F.lds, g, S, E);
    }
    SEAM(1);
    if (IN(2)) attn_naive_phase(F);
    SEAM(2);
    if (IN(3)) {
        { pg8::Gemm g{Y, (const bf16*)(p.ws + WS_WF), MT, DM, 512, DM, 512}; pg8::StaticOrder S; S.init(MT, DM, (int)gridDim.x, (int)blockIdx.x);
          pg8::EpiT E{Pb, T}; pg8::gemm_phase<pg8::EpiT, pg8::StaticOrder, true, true>(F.lds, g, S, E); }
        { pg8::Gemm g{Y + 512, (const bf16*)(p.ws + WS_WD), MT, DM, 512, DM, 512}; pg8::StaticOrder S; S.init(MT, DM, (int)gridDim.x, (int)blockIdx.x);
          pg8::EpiMG E{Pb, T, MG}; pg8::gemm_phase<pg8::EpiMG, pg8::StaticOrder, true, true>(F.lds, g, S, E); }
    }
    SEAM(3);
    if (IN(4)) {
        pg8::Gemm g{MG, (const bf16*)(p.ws + WS_WO), MT, DM, DM, DM, DM}; pg8::StaticOrder S; S.init(MT, DM, (int)gridDim.x, (int)blockIdx.x);
        pg8::EpiOut E{p.in[0], p.in[1], p.out}; pg8::gemm_phase<pg8::EpiOut, pg8::StaticOrder, true, true>(F.lds, g, S, E);
    }
    SEAM(4);
    if (IN(5)) final_norm_phase(F);
#undef IN
#undef SEAM
}

extern "C" void kernel_launch(void* const* d_in, const int* in_sizes, int n_in, void* d_out, int out_size, void* d_ws, size_t ws_size, hipStream_t stream) {
    static int grid = 0;
    if (grid == 0) {
        if (n_in != 20 || (size_t)out_size != O_END || ws_size < WS_END) { fprintf(stderr, "kernel_launch: unexpected shapes (n_in %d out %d ws %zu)\n", n_in, out_size, ws_size); grid = -1; return; }
        int dev = 0, cus = 0, per_cu = 0;
        hipGetDevice(&dev); hipDeviceGetAttribute(&cus, hipDeviceAttributeMultiprocessorCount, dev);
        if (hipFuncSetAttribute((const void*)fwd_kernel, hipFuncAttributeMaxDynamicSharedMemorySize, LDS_BYTES) != hipSuccess) { fprintf(stderr, "kernel_launch: hipFuncSetAttribute failed\n"); grid = -1; return; }
        if (hipOccupancyMaxActiveBlocksPerMultiprocessor(&per_cu, (const void*)fwd_kernel, 512, LDS_BYTES) != hipSuccess || per_cu < 1) { fprintf(stderr, "kernel_launch: occupancy query failed (%d)\n", per_cu); per_cu = 1; }
        (void)hipGetLastError();
        grid = cus * 1;
        fprintf(stderr, "kernel_launch: cus %d per_cu %d grid %d\n", cus, per_cu, grid);
    }
    if (grid < 0) return;
    Params p{};
    for (int i = 0; i < 20; ++i) p.in[i] = (const float*)d_in[i];
    p.out = (float*)d_out; p.ws = (unsigned char*)d_ws;
#if MK_MULTI
    for (int ph = 0; ph < NPHASE; ++ph) { p.ph_lo = ph; p.ph_hi = ph + 1; hipLaunchKernelGGL(fwd_kernel, dim3(grid), dim3(512), LDS_BYTES, stream, p); }
#else
    p.ph_lo = 0; p.ph_hi = NPHASE;
    void* args[] = {&p};
    hipError_t e = hipLaunchCooperativeKernel((const void*)fwd_kernel, dim3(grid), dim3(512), args, LDS_BYTES, stream);
    if (e != hipSuccess) fprintf(stderr, "kernel_launch: cooperative launch failed: %s (grid %d)\n", hipGetErrorString(e), grid);
#endif
}
```

```cpp
#include <hip/hip_runtime.h>
#include <hip/hip_cooperative_groups.h>
#include <cstdio>
#include <cstdint>
#include <cmath>
namespace cg = cooperative_groups;

namespace pg8 {
#define PG8_LAS __attribute__((address_space(3)))
typedef unsigned short bf16_t;
typedef short bf16x8 __attribute__((ext_vector_type(8)));
typedef float f32x4 __attribute__((ext_vector_type(4)));
typedef unsigned u32x4 __attribute__((ext_vector_type(4)));
constexpr int BM = 256, BK = 64, HALF = 128, HTB = HALF * BK * 2  , STAGE_BYTES = 8 * HTB, NXCD = 8, WGM = 8;

__host__ __device__ __forceinline__ int lds_byte(int r, int c) { const int st = (r >> 4) * 2 + (c >> 5), rr = r & 15, cc = c & 31, ob = rr * 64 + cc * 2; return st * 1024 + (ob ^ (((ob >> 9) & 1) << 5)); }
__host__ __device__ __forceinline__ void stage_rc(int b, int& R, int& C) { const int st = b / 1024, sb = b % 1024, swz = sb ^ (((sb >> 9) & 1) << 5); R = (st >> 1) * 16 + swz / 64; C = (st & 1) * 32 + (swz % 64) / 2; }
__host__ __device__ __forceinline__ int perm32(int rho) { const int n = rho >> 4, i = rho & 15; return 8 * (i >> 2) + 4 * n + (i & 3); }

struct Unit { int pm, pn; };
struct Gemm { const bf16_t* A; const bf16_t* Bt; int M, N, K, lda, ldb; };

struct StaticOrder {
    int nM, nN, nwg, G, c;
    __host__ __device__ void init(int M, int N, int G_, int c_) { nM = M / BM; nN = N / BM; nwg = nM * nN; G = G_; c = c_; }
    __host__ __device__ bool next(int i, Unit& u) const {
        const long L = (long)i * G + c; if (L >= nwg) return false;
        int wgid = (int)L; { const int q = nwg / NXCD, r = nwg % NXCD, xcd = wgid % NXCD, off = wgid / NXCD; wgid = (xcd < r ? xcd * (q + 1) : r * (q + 1) + (xcd - r) * q) + off; }
        const int nig = WGM * nN, gid = wgid / nig, fm = gid * WGM, gsz = (nM - fm) < WGM ? (nM - fm) : WGM;
        u.pm = fm + ((wgid % nig) % gsz); u.pn = (wgid % nig) / gsz; return true;
    }
    __device__ __forceinline__ void a_ready(const Unit&) const {}
    __device__ __forceinline__ void done(const Unit&) const {}
};


template <class Epi, class Sched, bool ALIGN_EPI = false, bool SP2 = false>
__device__ __forceinline__ void gemm_phase(PG8_LAS unsigned char* lds, const Gemm g, const Sched& S, const Epi& E) {
    const int tid = threadIdx.x, wid = __builtin_amdgcn_readfirstlane(tid >> 6), lane = tid & 63, wr = wid >> 2, wc = wid & 3, fr = lane & 15, fq = lane >> 4;
    const int K = g.K, nt = K / BK;
    unsigned voffA[2], voffB[2];
#pragma unroll
    for (int i = 0; i < 2; ++i) { int R, C; stage_rc(tid * 16 + i * 8192, R, C); const int Rb = Epi::PERM ? ((R & ~31) + perm32(R & 31)) : R;
        voffA[i] = (unsigned)(R * g.lda + C) * 2u; voffB[i] = (unsigned)(Rb * g.ldb + C) * 2u; }
    const size_t kstep = (size_t)(BK * 2);
    const size_t hstepA = (size_t)HALF * g.lda * 2, hstepB = (size_t)HALF * g.ldb * 2;
    const size_t tstepA = 2 * hstepA, tstepB = 2 * hstepB;
    const unsigned ldsw = (unsigned)wid * 1024u;
    const int aoff = lds_byte(wr * 64 + fr, fq * 8), boff = lds_byte(wc * 32 + fr, fq * 8);
#define PG8_SA(b, h) (((b) * 2 + (h)) * HTB)
#define PG8_SB(b, h) ((4 + (b) * 2 + (h)) * HTB)
#define PG8_STAGE(bufoff, gbase, voff) do { _Pragma("unroll") for (int _i = 0; _i < 2; ++_i) \
        __builtin_amdgcn_global_load_lds((const unsigned*)((const char*)(gbase) + (voff)[_i]), (PG8_LAS unsigned*)(lds + (bufoff) + ldsw + _i * 8192), 16, 0, 0); } while (0)
#define PG8_LDA(dst, b, h) do { _Pragma("unroll") for (int m = 0; m < 4; ++m) _Pragma("unroll") for (int k = 0; k < 2; ++k) dst[m][k] = *(const PG8_LAS bf16x8*)(lds + PG8_SA(b, h) + aoff + m * 2048 + k * 1024); } while (0)
#define PG8_LDB(dst, b, h) do { _Pragma("unroll") for (int n = 0; n < 2; ++n) _Pragma("unroll") for (int k = 0; k < 2; ++k) dst[n][k] = *(const PG8_LAS bf16x8*)(lds + PG8_SB(b, h) + boff + n * 2048 + k * 1024); } while (0)
#define PG8_MMA(ai, bj, At, Bt) do { __builtin_amdgcn_s_setprio(1); _Pragma("unroll") for (int m = 0; m < 4; ++m) _Pragma("unroll") for (int n = 0; n < 2; ++n) _Pragma("unroll") for (int k = 0; k < 2; ++k) \
        acc[ai][bj][m][n] = __builtin_amdgcn_mfma_f32_16x16x32_bf16(Bt[n][k], At[m][k], acc[ai][bj][m][n], 0, 0, 0); __builtin_amdgcn_s_setprio(0); } while (0)
#define PG8_WAIT_V(n) asm volatile("s_waitcnt vmcnt(" #n ")" ::: "memory")
#define PG8_WAIT_L(n) asm volatile("s_waitcnt lgkmcnt(" #n ")" ::: "memory")
#define PG8_BAR __builtin_amdgcn_s_barrier()
#define PG8_SCHED __builtin_amdgcn_sched_barrier(0)
    Unit cur, nxt; int ui = 0;
    if (!S.next(0, cur)) return;
    f32x4 acc[2][2][4][2];
#pragma unroll
    for (int a = 0; a < 2; ++a)
#pragma unroll
        for (int b = 0; b < 2; ++b)
#pragma unroll
            for (int m = 0; m < 4; ++m)
#pragma unroll
                for (int n = 0; n < 2; ++n) acc[a][b][m][n] = (f32x4){0.f, 0.f, 0.f, 0.f};
    bf16x8 At[4][2], B0[2][2], B1[2][2];
    const char* cA = (const char*)g.A + (size_t)cur.pm * tstepA; const char* cB = (const char*)g.Bt + (size_t)cur.pn * tstepB;
    S.a_ready(cur);
    if constexpr (SP2) {
        PG8_STAGE(PG8_SB(0, 0), cB, voffB); PG8_STAGE(PG8_SB(0, 1), cB + hstepB, voffB); PG8_STAGE(PG8_SA(0, 0), cA, voffA); PG8_STAGE(PG8_SA(0, 1), cA + hstepA, voffA);
        if (wr == 1) PG8_BAR;
        PG8_WAIT_V(2); PG8_BAR;
        PG8_STAGE(PG8_SB(1, 0), cB + kstep, voffB); PG8_STAGE(PG8_SA(1, 0), cA + kstep, voffA); PG8_STAGE(PG8_SB(1, 1), cB + hstepB + kstep, voffB);
        PG8_WAIT_V(6); PG8_BAR;
    } else {
        PG8_STAGE(PG8_SB(0, 0), cB, voffB); PG8_STAGE(PG8_SA(0, 0), cA, voffA); PG8_STAGE(PG8_SB(0, 1), cB + hstepB, voffB); PG8_STAGE(PG8_SA(0, 1), cA + hstepA, voffA);
        if (wr == 1) PG8_BAR;
        PG8_WAIT_V(4); PG8_BAR;
        PG8_STAGE(PG8_SB(1, 0), cB + kstep, voffB); PG8_STAGE(PG8_SA(1, 0), cA + kstep, voffA); PG8_STAGE(PG8_SB(1, 1), cB + hstepB + kstep, voffB);
        PG8_WAIT_V(6); PG8_BAR;
    }
    for (;;) {
        const bool has_next = S.next(ui + 1, nxt);
        const char* nA = has_next ? (const char*)g.A + (size_t)nxt.pm * tstepA : cA; const char* nB = has_next ? (const char*)g.Bt + (size_t)nxt.pn * tstepB : cB;
        for (int t = 0; t < nt; t += 2) {
            const bool last = (t == nt - 2);
            const char* a1 = cA + (size_t)(t + 1) * kstep;
            const char* a2 = last ? nA : cA + (size_t)(t + 2) * kstep; const char* b2 = last ? nB : cB + (size_t)(t + 2) * kstep;
            const char* a3 = a2 + kstep; const char* b3 = b2 + kstep;
            if (last && has_next) S.a_ready(nxt);
            if constexpr (SP2) {
            PG8_LDB(B0, 0, 0); PG8_LDB(B1, 0, 1); PG8_SCHED; PG8_LDA(At, 0, 0); PG8_STAGE(PG8_SA(1, 1), a1 + hstepA, voffA);
            PG8_WAIT_V(8); PG8_WAIT_L(0); PG8_BAR; PG8_MMA(0, 0, At, B0); PG8_MMA(0, 1, At, B1); PG8_BAR; PG8_SCHED;
            PG8_LDA(At, 0, 1); PG8_STAGE(PG8_SB(0, 0), b2, voffB); PG8_STAGE(PG8_SB(0, 1), b2 + hstepB, voffB); PG8_STAGE(PG8_SA(0, 0), a2, voffA);
            PG8_WAIT_V(8); PG8_WAIT_L(0); PG8_BAR; PG8_MMA(1, 0, At, B0); PG8_MMA(1, 1, At, B1); PG8_BAR; PG8_SCHED;
            PG8_LDB(B0, 1, 0); PG8_LDB(B1, 1, 1); PG8_SCHED; PG8_LDA(At, 1, 0); PG8_STAGE(PG8_SA(0, 1), a2 + hstepA, voffA);
            PG8_WAIT_V(8); PG8_WAIT_L(0); PG8_BAR; PG8_MMA(0, 0, At, B0); PG8_MMA(0, 1, At, B1); PG8_BAR; PG8_SCHED;
            PG8_LDA(At, 1, 1); PG8_STAGE(PG8_SB(1, 0), b3, voffB); PG8_STAGE(PG8_SB(1, 1), b3 + hstepB, voffB); PG8_STAGE(PG8_SA(1, 0), a3, voffA);
            PG8_WAIT_V(8); PG8_WAIT_L(0); PG8_BAR; PG8_MMA(1, 0, At, B0); PG8_MMA(1, 1, At, B1); PG8_BAR; PG8_SCHED;
            } else {
            PG8_LDB(B0, 0, 0); PG8_SCHED; PG8_LDA(At, 0, 0); PG8_STAGE(PG8_SA(1, 1), a1 + hstepA, voffA);
            PG8_WAIT_L(8); PG8_BAR; PG8_WAIT_L(0); PG8_MMA(0, 0, At, B0); PG8_BAR; PG8_SCHED;
            PG8_LDB(B1, 0, 1); PG8_STAGE(PG8_SB(0, 0), b2, voffB);
            PG8_BAR; PG8_WAIT_L(0); PG8_MMA(0, 1, At, B1); PG8_BAR;
            PG8_LDA(At, 0, 1); PG8_STAGE(PG8_SA(0, 0), a2, voffA);
            PG8_BAR; PG8_WAIT_L(0); PG8_MMA(1, 0, At, B0); PG8_BAR; PG8_SCHED;
            PG8_STAGE(PG8_SB(0, 1), b2 + hstepB, voffB);
            PG8_WAIT_V(6); PG8_BAR; PG8_MMA(1, 1, At, B1); PG8_BAR;
            PG8_LDB(B0, 1, 0); PG8_SCHED; PG8_LDA(At, 1, 0); PG8_STAGE(PG8_SA(0, 1), a2 + hstepA, voffA);
            PG8_WAIT_L(8); PG8_BAR; PG8_WAIT_L(0); PG8_MMA(0, 0, At, B0); PG8_BAR; PG8_SCHED;
            PG8_LDB(B1, 1, 1); PG8_STAGE(PG8_SB(1, 0), b3, voffB);
            PG8_BAR; PG8_WAIT_L(0); PG8_MMA(0, 1, At, B1); PG8_BAR;
            PG8_LDA(At, 1, 1); PG8_STAGE(PG8_SA(1, 0), a3, voffA);
            PG8_BAR; PG8_WAIT_L(0); PG8_MMA(1, 0, At, B0); PG8_BAR; PG8_SCHED;
            PG8_STAGE(PG8_SB(1, 1), b3 + hstepB, voffB);
            PG8_WAIT_V(6); PG8_BAR; PG8_MMA(1, 1, At, B1); PG8_BAR;
            }
        }
        if constexpr (ALIGN_EPI) { if (wr == 0) PG8_BAR; }
        if constexpr (!Epi::AFTER_DRAIN) { E(acc, cur, wr, wc, fr, fq); S.done(cur); }
        if (!has_next) break;
#pragma unroll
        for (int a = 0; a < 2; ++a)
#pragma unroll
            for (int b = 0; b < 2; ++b)
#pragma unroll
                for (int m = 0; m < 4; ++m)
#pragma unroll
                    for (int n = 0; n < 2; ++n) acc[a][b][m][n] = (f32x4){0.f, 0.f, 0.f, 0.f};
        cur = nxt; cA = nA; cB = nB; ++ui;
        if constexpr (ALIGN_EPI) { if (wr == 1) PG8_BAR; }
    }
    PG8_WAIT_V(0);
    if constexpr (!ALIGN_EPI) { if (wr == 0) PG8_BAR; }
    PG8_BAR;
    if constexpr (Epi::AFTER_DRAIN) { E.fused(acc, cur, wr, wc, fr, fq, lds, wid, lane); S.done(cur); }
#undef PG8_SA
#undef PG8_SB
#undef PG8_STAGE
#undef PG8_LDA
#undef PG8_LDB
#undef PG8_MMA
#undef PG8_WAIT_V
#undef PG8_WAIT_L
#undef PG8_BAR
#undef PG8_SCHED
}
}


typedef unsigned short bf16;
typedef unsigned u32x4 __attribute__((ext_vector_type(4)));
typedef float f32x4 __attribute__((ext_vector_type(4)));
#define LAS __attribute__((address_space(3)))
constexpr int DM = 1024, MP = 32768, MS = 512, MT = MP + MS;
constexpr int TP = 4096, TS = 16, PAST = 2048, KS = PAST + TS;
constexpr int NPROJ = 6144, INW = 6152;
constexpr int C_FQ = 0, C_FK = 512, C_FV = 1024, C_FZ = 1536, C_DQ = 2048, C_DK = 2560, C_DV = 3072, C_DZ = 3584, C_GA = 4096, C_GB = 5120;
constexpr size_t O_YP = 0, O_YS = 33554432, O_FKP = 34078720, O_FVP = 50855936, O_FLP = 67633152, O_DKP = 67895296, O_DVP = 84672512,
                 O_FKS = 101449728, O_FVS = 101711872, O_FLS = 101974016, O_DKS = 101978112, O_DVS = 102240256, O_END = 102502400;
constexpr size_t MiB = 1u << 20;
constexpr size_t WS_CTL = 0, WS_WIN = 2 * MiB, WS_WF = 14 * MiB, WS_WD = 15 * MiB, WS_WO = 16 * MiB, WS_CUMP = 18 * MiB, WS_CUMS = 19 * MiB, WS_QX = 22 * MiB, WS_KX = 27 * MiB,
                 WS_XN = 32 * MiB  , WS_P = 98 * MiB  , WS_Y = 488 * MiB  , WS_MG = 554 * MiB  , WS_END = 620 * MiB;
constexpr float LOG2E = 1.4426950408889634f, C2 = 0.125f * 1.4426950408889634f, NORM_EPS = 1e-6f;
constexpr int LDS_BYTES = 147456;
constexpr int NPHASE = 7;

struct Params { const float* in[20]; float* out; unsigned char* ws; int ph_lo, ph_hi; };

__device__ __forceinline__ unsigned f2bf(float f) { unsigned u = __builtin_bit_cast(unsigned, f); return (u + 0x7fffu + ((u >> 16) & 1u)) >> 16; }
__device__ __forceinline__ unsigned pk2(float lo, float hi) { return f2bf(lo) | (f2bf(hi) << 16); }
__device__ __forceinline__ float bf2f(unsigned short b) { return __uint_as_float((unsigned)b << 16); }
__device__ __forceinline__ float bflo(unsigned w) { return __uint_as_float(w << 16); }
__device__ __forceinline__ float bfhi(unsigned w) { return __uint_as_float(w & 0xffff0000u); }
__device__ __forceinline__ float wave_sum(float v) {
#pragma unroll
    for (int o = 1; o < 64; o <<= 1) v += __shfl_xor(v, o);
    return v;
}
__device__ __forceinline__ float wave_max(float v) {
#pragma unroll
    for (int o = 1; o < 64; o <<= 1) v = fmaxf(v, __shfl_xor(v, o));
    return v;
}
__device__ __forceinline__ float sigmoidf_(float z) { return __builtin_amdgcn_rcpf(1.f + __builtin_amdgcn_exp2f(-z * LOG2E)); }

namespace pg8 {
struct EpiProj {
    static constexpr bool PERM = true, AFTER_DRAIN = false;
    bf16_t* P; float* out;
    __device__ __forceinline__ void operator()(const f32x4 (&acc)[2][2][4][2], const Unit& u, int wr, int wc, int fr, int fq) const {
        const int colt = u.pn * BM, seg = colt >> 9;
        const bool samp = u.pm >= (MP / BM);
        int op; float* fo = nullptr;
        if (seg == 0 || seg == 4) op = 0; else if (seg == 3 || seg == 7) op = 2; else if (seg >= 8) op = 3;
        else { op = 1; const size_t ob = seg == 1 ? (samp ? O_FKS : O_FKP) : seg == 2 ? (samp ? O_FVS : O_FVP) : seg == 5 ? (samp ? O_DKS : O_DKP) : (samp ? O_DVS : O_DVP); fo = out + ob; }
        const int row0 = u.pm * BM + wr * 64 + fr, col0 = colt + wc * 32 + 8 * fq, scol0 = col0 - (seg << 9);
#pragma unroll
        for (int ai = 0; ai < 2; ++ai)
#pragma unroll
            for (int m = 0; m < 4; ++m) { const int r = row0 + ai * HALF + m * 16; bf16_t* rowp = P + (size_t)r * NPROJ + col0; const int rr = samp ? r - MP : r;
#pragma unroll
                for (int bj = 0; bj < 2; ++bj) { f32x4 v0 = acc[ai][bj][m][0], v1 = acc[ai][bj][m][1];
                    if (op == 1) { float* fp = fo + (size_t)rr * 512 + scol0 + bj * HALF; *(f32x4*)fp = v0; *(f32x4*)(fp + 4) = v1; }
                    else if (op == 0) { v0 = v0 * C2; v1 = v1 * C2; }
                    else {
#pragma unroll
                        for (int e = 0; e < 4; ++e) { const float s0 = sigmoidf_(v0[e]), s1 = sigmoidf_(v1[e]); v0[e] = op == 2 ? v0[e] * s0 : s0; v1[e] = op == 2 ? v1[e] * s1 : s1; } }
                    u32x4 w; w.x = pk2(v0[0], v0[1]); w.y = pk2(v0[2], v0[3]); w.z = pk2(v1[0], v1[1]); w.w = pk2(v1[2], v1[3]);
                    *(u32x4*)(rowp + bj * HALF) = w; } }
    }
};
struct EpiT {
    static constexpr bool PERM = true, AFTER_DRAIN = false;
    const bf16_t* P; bf16_t* T;
    __device__ __forceinline__ void operator()(const f32x4 (&acc)[2][2][4][2], const Unit& u, int wr, int wc, int fr, int fq) const {
        const int row0 = u.pm * BM + wr * 64 + fr, col0 = u.pn * BM + wc * 32 + 8 * fq;
#pragma unroll
        for (int ai = 0; ai < 2; ++ai)
#pragma unroll
            for (int m = 0; m < 4; ++m) { const int r = row0 + ai * HALF + m * 16;
#pragma unroll
                for (int bj = 0; bj < 2; ++bj) { const int c = col0 + bj * HALF; const f32x4 v0 = acc[ai][bj][m][0], v1 = acc[ai][bj][m][1];
                    const u32x4 g = *(const u32x4*)(P + (size_t)r * NPROJ + C_GA + c);
                    u32x4 w; w.x = pk2(v0[0] * bflo(g.x), v0[1] * bfhi(g.x)); w.y = pk2(v0[2] * bflo(g.y), v0[3] * bfhi(g.y)); w.z = pk2(v1[0] * bflo(g.z), v1[1] * bfhi(g.z)); w.w = pk2(v1[2] * bflo(g.w), v1[3] * bfhi(g.w));
                    *(u32x4*)(T + (size_t)r * DM + c) = w; } }
    }
};
struct EpiMG {
    static constexpr bool PERM = true, AFTER_DRAIN = false;
    const bf16_t* P; const bf16_t* T; bf16_t* MG;
    __device__ __forceinline__ void operator()(const f32x4 (&acc)[2][2][4][2], const Unit& u, int wr, int wc, int fr, int fq) const {
        const int row0 = u.pm * BM + wr * 64 + fr, col0 = u.pn * BM + wc * 32 + 8 * fq;
#pragma unroll
        for (int ai = 0; ai < 2; ++ai)
#pragma unroll
            for (int m = 0; m < 4; ++m) { const int r = row0 + ai * HALF + m * 16;
#pragma unroll
                for (int bj = 0; bj < 2; ++bj) { const int c = col0 + bj * HALF; const f32x4 v0 = acc[ai][bj][m][0], v1 = acc[ai][bj][m][1];
                    const u32x4 g = *(const u32x4*)(P + (size_t)r * NPROJ + C_GB + c); const u32x4 t = *(const u32x4*)(T + (size_t)r * DM + c);
                    u32x4 w; w.x = pk2(bflo(t.x) + v0[0] * bflo(g.x), bfhi(t.x) + v0[1] * bfhi(g.x)); w.y = pk2(bflo(t.y) + v0[2] * bflo(g.y), bfhi(t.y) + v0[3] * bfhi(g.y));
                    w.z = pk2(bflo(t.z) + v1[0] * bflo(g.z), bfhi(t.z) + v1[1] * bfhi(g.z)); w.w = pk2(bflo(t.w) + v1[2] * bflo(g.w), bfhi(t.w) + v1[3] * bfhi(g.w));
                    *(u32x4*)(MG + (size_t)r * DM + c) = w; } }
    }
};
struct EpiOut {
    static constexpr bool PERM = true, AFTER_DRAIN = false;
    const float* xp; const float* xs; float* out;
    __device__ __forceinline__ void operator()(const f32x4 (&acc)[2][2][4][2], const Unit& u, int wr, int wc, int fr, int fq) const {
        const int row0 = u.pm * BM + wr * 64 + fr, col0 = u.pn * BM + wc * 32 + 8 * fq;
        const bool samp = u.pm >= (MP / BM);
#pragma unroll
        for (int ai = 0; ai < 2; ++ai)
#pragma unroll
            for (int m = 0; m < 4; ++m) { const int r = row0 + ai * HALF + m * 16; const float* xr = samp ? xs + (size_t)(r - MP) * DM : xp + (size_t)r * DM;
#pragma unroll
                for (int bj = 0; bj < 2; ++bj) { const int c = col0 + bj * HALF;
                    const f32x4 x0 = *(const f32x4*)(xr + c), x1 = *(const f32x4*)(xr + c + 4);
                    *(f32x4*)(out + (size_t)r * DM + c) = x0 + acc[ai][bj][m][0]; *(f32x4*)(out + (size_t)r * DM + c + 4) = x1 + acc[ai][bj][m][1]; } }
    }
};
}

struct Frame {
    LAS unsigned char* lds; int tid, lane, wave, gw, ngw;
    const float* const* in; float* out; unsigned char* ws;
};

__device__ __forceinline__ void transpose_item(const float* W, int ldw, int c0, int k0, bf16* WT, int ldt, int n0, LAS float* scr, int lane) {
#pragma unroll 8
    for (int i = 0; i < 32; ++i) { const int kk = 2 * i + (lane >> 5); scr[kk * 33 + (lane & 31)] = W[(size_t)(k0 + kk) * ldw + c0 + (lane & 31)]; }
    asm volatile("s_waitcnt lgkmcnt(0)" ::: "memory");
    const int c = lane & 7;
#pragma unroll
    for (int j = 0; j < 4; ++j) { const int n = (lane >> 3) + 8 * j; const LAS float* s = scr + (8 * c) * 33 + n;
        u32x4 o; o.x = pk2(s[0 * 33], s[1 * 33]); o.y = pk2(s[2 * 33], s[3 * 33]); o.z = pk2(s[4 * 33], s[5 * 33]); o.w = pk2(s[6 * 33], s[7 * 33]);
        *(u32x4*)(WT + (size_t)(n0 + n) * ldt + k0 + 8 * c) = o; }
    asm volatile("s_waitcnt lgkmcnt(0)" ::: "memory");
}
__device__ __forceinline__ float log_sigmoid_f(float z) { return fminf(z, 0.f) - log1pf(expf(-fabsf(z))); }

__device__ __forceinline__ void phase0(const Frame& F) {
    const float* w_in = F.in[8]; const float* wuf = F.in[15]; const float* wud = F.in[16]; const float* wo = F.in[17];
    bf16* WIN = (bf16*)(F.ws + WS_WIN); bf16* WF = (bf16*)(F.ws + WS_WF); bf16* WD = (bf16*)(F.ws + WS_WD); bf16* WO = (bf16*)(F.ws + WS_WO);
    LAS float* scr = (LAS float*)(F.lds + F.wave * 16384);
    constexpr int I_IN = 16 * 192, I_UP = 8 * 32, I_O = 16 * 32, NITEMS = I_IN + 2 * I_UP + I_O;
    for (int it = F.gw; it < NITEMS; it += F.ngw) {
        int r = it;
        if (r < I_IN) { const int kb = r / 192, nb = r % 192, n0 = nb * 32; transpose_item(w_in, INW, n0 + (n0 >= 2048 ? 8 : 0), kb * 64, WIN, DM, n0, scr, F.lane); continue; } r -= I_IN;
        if (r < I_UP) { const int kb = r / 32, nb = r % 32; transpose_item(wuf, DM, nb * 32, kb * 64, WF, 512, nb * 32, scr, F.lane); continue; } r -= I_UP;
        if (r < I_UP) { const int kb = r / 32, nb = r % 32; transpose_item(wud, DM, nb * 32, kb * 64, WD, 512, nb * 32, scr, F.lane); continue; } r -= I_UP;
        { const int kb = r / 32, nb = r % 32; transpose_item(wo, DM, nb * 32, kb * 64, WO, DM, nb * 32, scr, F.lane); }
    }
    __syncthreads();
    LAS float* wgT = (LAS float*)F.lds; const float* gin = F.in[7];
    for (int i = F.tid; i < 8 * DM; i += 512) { const int j = i >> 10, k = i & 1023; wgT[i] = gin[k] * w_in[(size_t)k * INW + 2048 + j]; }
    __syncthreads();
    const float* xp = F.in[0]; const float* xs = F.in[1]; const float* bfg = F.in[9];
    bf16* XN = (bf16*)(F.ws + WS_XN);
    for (int m = F.gw; m < MT; m += F.ngw) {
        const float* xrow = m < MP ? xp + (size_t)m * DM : xs + (size_t)(m - MP) * DM;
        f32x4 v[4]; float ss = 0.f;
#pragma unroll
        for (int j = 0; j < 4; ++j) { v[j] = *(const f32x4*)(xrow + 4 * (F.lane + 64 * j)); ss += (v[j][0] * v[j][0] + v[j][1] * v[j][1]) + (v[j][2] * v[j][2] + v[j][3] * v[j][3]); }
        const float rstd = 1.0f / sqrtf(wave_sum(ss) * (1.f / DM) + NORM_EPS);
        float fl[8];
#pragma unroll
        for (int jj = 0; jj < 8; ++jj) { float a = 0.f;
#pragma unroll
            for (int j = 0; j < 4; ++j) { const f32x4 w = *(const LAS f32x4*)(wgT + jj * DM + 4 * (F.lane + 64 * j)); a += (v[j][0] * w[0] + v[j][1] * w[1]) + (v[j][2] * w[2] + v[j][3] * w[3]); }
            fl[jj] = wave_sum(a) * rstd; }
        float mine = fl[0];
#pragma unroll
        for (int jj = 1; jj < 8; ++jj) mine = (F.lane == jj) ? fl[jj] : mine;
        if (F.lane < 8) { const float lf = log_sigmoid_f(mine + bfg[F.lane]);
            if (m < MP) F.out[O_FLP + (size_t)m * 8 + F.lane] = lf; else F.out[O_FLS + (size_t)(m - MP) * 8 + F.lane] = lf; }
#pragma unroll
        for (int j = 0; j < 4; ++j) { const f32x4 g = *(const f32x4*)(gin + 4 * (F.lane + 64 * j));
            const unsigned lo = pk2(v[j][0] * rstd * g[0], v[j][1] * rstd * g[1]), hi = pk2(v[j][2] * rstd * g[2], v[j][3] * rstd * g[3]);
            *(unsigned long long*)(XN + (size_t)m * DM + 4 * (F.lane + 64 * j)) = (unsigned long long)lo | ((unsigned long long)hi << 32); }
    }
}

__device__ __forceinline__ double wave_excl_scan(double s, int lane) {
    double inc = s;
#pragma unroll
    for (int o = 1; o < 64; o <<= 1) { const double t = __shfl_up(inc, o); if (lane >= o) inc += t; }
    return inc - s;
}
__device__ __forceinline__ void scan_phase(const Frame& F) {
    float* cumP = (float*)(F.ws + WS_CUMP); float* cumS = (float*)(F.ws + WS_CUMS);
    if (F.gw < 64) {
        const int b = F.gw >> 3, h = F.gw & 7; const float* src = F.out + O_FLP + (size_t)b * TP * 8 + h;
        double s = 0.0;
        for (int i = 0; i < 64; ++i) s += (double)src[(size_t)(F.lane * 64 + i) * 8];
        double run = wave_excl_scan(s, F.lane);
        float* dst = cumP + (size_t)(b * 8 + h) * TP + F.lane * 64;
        u32x4* qx = (u32x4*)(F.ws + WS_QX) + ((size_t)(b * TP + F.lane * 64) * 8 + h); u32x4* kx = (u32x4*)(F.ws + WS_KX) + ((size_t)(b * TP + F.lane * 64) * 8 + h);
        for (int i = 0; i < 64; ++i) { run += (double)src[(size_t)(F.lane * 64 + i) * 8]; dst[i] = (float)run;
            const float c = (float)(run * 1.4426950408889634);
            const unsigned ch = f2bf(c); const float r1 = c - bf2f((unsigned short)ch); const unsigned cm = f2bf(r1); const float r2 = r1 - bf2f((unsigned short)cm); const unsigned cl = f2bf(r2);
            const unsigned one = 0x3F80u;
            qx[(size_t)i * 8] = (u32x4){ch | (cm << 16), cl | (one << 16), one | (one << 16), 0u};
            kx[(size_t)i * 8] = (u32x4){one | (one << 16), one | ((ch ^ 0x8000u) << 16), (cm ^ 0x8000u) | ((cl ^ 0x8000u) << 16), 0u}; }
    } else if (F.gw < 64 + 256) {
        const int g = F.gw - 64, b = g >> 3, h = g & 7; const float* past = F.in[4] + (size_t)b * PAST * 8 + h; const float* nw = F.out + O_FLS + (size_t)b * TS * 8 + h;
        double s = 0.0;
        for (int i = 0; i < 33; ++i) { const int j = F.lane * 33 + i; if (j < KS) s += (double)(j < PAST ? past[(size_t)j * 8] : nw[(size_t)(j - PAST) * 8]); }
        double run = wave_excl_scan(s, F.lane);
        float* dst = cumS + (size_t)(b * 8 + h) * KS;
        for (int i = 0; i < 33; ++i) { const int j = F.lane * 33 + i; if (j < KS) { run += (double)(j < PAST ? past[(size_t)j * 8] : nw[(size_t)(j - PAST) * 8]); dst[j] = (float)run; } }
    }
}

__device__ __forceinline__ int t5_bucket(int rel) {
    const int n = rel < 0 ? -rel : rel; int b;
    if (n < 8) b = n; else if (n < 12) b = 8; else if (n < 16) b = 9; else if (n < 23) b = 10; else if (n < 32) b = 11; else if (n < 46) b = 12; else if (n < 64) b = 13; else if (n < 91) b = 14; else b = 15;
    return (rel > 0 ? 16 : 0) + b;
}
struct QVec { float q[64]; };
__device__ __forceinline__ void load_q(QVec& Q, const bf16* p) {
#pragma unroll
    for (int c = 0; c < 8; ++c) { const u32x4 w = *(const u32x4*)(p + 8 * c);
        Q.q[8 * c + 0] = bflo(w.x); Q.q[8 * c + 1] = bfhi(w.x); Q.q[8 * c + 2] = bflo(w.y); Q.q[8 * c + 3] = bfhi(w.y); Q.q[8 * c + 4] = bflo(w.z); Q.q[8 * c + 5] = bfhi(w.z); Q.q[8 * c + 6] = bflo(w.w); Q.q[8 * c + 7] = bfhi(w.w); }
}
__device__ __forceinline__ float dot_bf16(const QVec& Q, const bf16* p) {
    float s = 0.f;
#pragma unroll
    for (int c = 0; c < 8; ++c) { const u32x4 w = *(const u32x4*)(p + 8 * c);
        s += Q.q[8 * c + 0] * bflo(w.x); s += Q.q[8 * c + 1] * bfhi(w.x); s += Q.q[8 * c + 2] * bflo(w.y); s += Q.q[8 * c + 3] * bfhi(w.y);
        s += Q.q[8 * c + 4] * bflo(w.z); s += Q.q[8 * c + 5] * bfhi(w.z); s += Q.q[8 * c + 6] * bflo(w.w); s += Q.q[8 * c + 7] * bfhi(w.w); }
    return s;
}
__device__ __forceinline__ float dot_f32(const QVec& Q, const float* p) {
    float s = 0.f;
#pragma unroll
    for (int c = 0; c < 16; ++c) { const f32x4 w = *(const f32x4*)(p + 4 * c); s += Q.q[4 * c] * w[0]; s += Q.q[4 * c + 1] * w[1]; s += Q.q[4 * c + 2] * w[2]; s += Q.q[4 * c + 3] * w[3]; }
    return s;
}
template <int NE, class Score, class Val>
__device__ __forceinline__ void naive_attn(int nkeys, Score score, Val val, float (&o)[NE], int lane) {
    float m = -INFINITY, l = 0.f;
#pragma unroll
    for (int e = 0; e < NE; ++e) o[e] = 0.f;
    for (int j0 = 0; j0 < nkeys; j0 += 64) {
        const int j = j0 + lane; const bool valid = j < nkeys;
        float s = -INFINITY; if (valid) s = score(j);
        const float mn = fmaxf(m, wave_max(s));
        const float alpha = exp2f(m - mn), pj = valid ? exp2f(s - mn) : 0.f;
        l = l * alpha + wave_sum(pj);
#pragma unroll
        for (int e = 0; e < NE; ++e) o[e] *= alpha;
        const int nj = (nkeys - j0) < 64 ? (nkeys - j0) : 64;
        for (int jj = 0; jj < nj; ++jj) { const float pb = __shfl(pj, jj);
#pragma unroll
            for (int e = 0; e < NE; ++e) o[e] += pb * val(j0 + jj, e); }
        m = mn;
    }
    const float il = 1.f / l;
#pragma unroll
    for (int e = 0; e < NE; ++e) o[e] *= il;
}
#ifndef NAIVE_PROMPT
#define NAIVE_PROMPT 0
#endif
__device__ __forceinline__ void attn_naive_phase(const Frame& F) {
    const bf16* P = (const bf16*)(F.ws + WS_P); bf16* Y = (bf16*)(F.ws + WS_Y);
    const float* cumP = (const float*)(F.ws + WS_CUMP); const float* cumS = (const float*)(F.ws + WS_CUMS);
    const float* cfk = F.in[2]; const float* cfv = F.in[3]; const float* cdk = F.in[5]; const float* cdv = F.in[6];
    const float* tbl = F.in[18]; const float* sg = F.in[14];
    const int lane = F.lane;
    const float lam = expf(wave_sum(F.in[10][lane] * F.in[11][lane])) - expf(wave_sum(F.in[12][lane] * F.in[13][lane])) + 0.2f;
    for (int it = F.gw; it < (NAIVE_PROMPT ? MP * 8 : 0); it += F.ngw) {
        const int h = it & 7, m = it >> 3, b = m >> 12, t = m & 4095;
        const bf16* Pm = P + (size_t)m * NPROJ; const bf16* Pb = P + (size_t)(b * TP) * NPROJ;
        QVec Q; load_q(Q, Pm + C_FQ + h * 64);
        const float* cum = cumP + (size_t)(b * 8 + h) * TP; const float cq = cum[t];
        float o[1];
        naive_attn<1>(t + 1, [&](int j) { return dot_bf16(Q, Pb + (size_t)j * NPROJ + C_FK + h * 64) + (cq - cum[j]) * LOG2E; },
                      [&](int j, int e) { return bf2f(Pb[(size_t)j * NPROJ + C_FV + h * 64 + lane]); }, o, lane);
        Y[(size_t)m * DM + h * 64 + lane] = (bf16)f2bf(o[0] * bf2f(Pm[C_FZ + h * 64 + lane]));
    }
    for (int it = F.gw; it < MS * 8; it += F.ngw) {
        const int h = it & 7, ms = it >> 3, b = ms >> 4, t = ms & 15, m = MP + ms;
        const bf16* Pm = P + (size_t)m * NPROJ; const bf16* Pn = P + (size_t)(MP + b * TS) * NPROJ;
        QVec Q; load_q(Q, Pm + C_FQ + h * 64);
        const float* cum = cumS + (size_t)(b * 8 + h) * KS; const float cq = cum[PAST + t];
        const float* kb = cfk + ((size_t)b * PAST * 8 + h) * 64; const float* vb = cfv + ((size_t)b * PAST * 8 + h) * 64;
        float o[1];
        naive_attn<1>(PAST + t + 1, [&](int j) { return (j < PAST ? dot_f32(Q, kb + (size_t)j * 512) : dot_bf16(Q, Pn + (size_t)(j - PAST) * NPROJ + C_FK + h * 64)) + (cq - cum[j]) * LOG2E; },
                      [&](int j, int e) { return j < PAST ? vb[(size_t)j * 512 + lane] : bf2f(Pn[(size_t)(j - PAST) * NPROJ + C_FV + h * 64 + lane]); }, o, lane);
        Y[(size_t)m * DM + h * 64 + lane] = (bf16)f2bf(o[0] * bf2f(Pm[C_FZ + h * 64 + lane]));
    }
    for (int it = F.gw + (NAIVE_PROMPT ? 0 : MP * 4); it < (MP + MS) * 4; it += F.ngw) {
        const int h = it & 3, m = it >> 2; const bool samp = m >= MP;
        const int b = samp ? (m - MP) >> 4 : m >> 12, t = samp ? (m - MP) & 15 : m & 4095;
        const bf16* Pm = P + (size_t)m * NPROJ; const bf16* Pb = samp ? P + (size_t)(MP + b * TS) * NPROJ : P + (size_t)(b * TP) * NPROJ;
        const int qpos = samp ? PAST + t : t, nkeys = samp ? KS : ((t >> 6) + 1) * 64;
        const float* kb = cdk + ((size_t)b * PAST * 4 + h) * 128; const float* vb = cdv + ((size_t)b * PAST * 4 + h) * 128;
        float oo[2][2];
#pragma unroll
        for (int mm = 0; mm < 2; ++mm) {
            QVec Q; load_q(Q, Pm + C_DQ + h * 128 + mm * 64);
            if (samp) naive_attn<2>(nkeys, [&](int j) { return (j < PAST ? dot_f32(Q, kb + (size_t)j * 512 + mm * 64) : dot_bf16(Q, Pb + (size_t)(j - PAST) * NPROJ + C_DK + h * 128 + mm * 64)) + tbl[t5_bucket(j - qpos) * 4 + h] * LOG2E; },
                                    [&](int j, int e) { return j < PAST ? vb[(size_t)j * 512 + e * 64 + lane] : bf2f(Pb[(size_t)(j - PAST) * NPROJ + C_DV + h * 128 + e * 64 + lane]); }, oo[mm], lane);
            else naive_attn<2>(nkeys, [&](int j) { return dot_bf16(Q, Pb + (size_t)j * NPROJ + C_DK + h * 128 + mm * 64) + tbl[t5_bucket(j - qpos) * 4 + h] * LOG2E; },
                               [&](int j, int e) { return bf2f(Pb[(size_t)j * NPROJ + C_DV + h * 128 + e * 64 + lane]); }, oo[mm], lane);
        }
        const float d0 = oo[0][0] - lam * oo[1][0], d1 = oo[0][1] - lam * oo[1][1];
        const float r = 1.0f / sqrtf(wave_sum(d0 * d0 + d1 * d1) * (1.f / 128.f) + NORM_EPS);
        Y[(size_t)m * DM + 512 + h * 128 + lane] = (bf16)f2bf(d0 * r * sg[lane] * 0.8f * bf2f(Pm[C_DZ + h * 128 + lane]));
        Y[(size_t)m * DM + 512 + h * 128 + 64 + lane] = (bf16)f2bf(d1 * r * sg[64 + lane] * 0.8f * bf2f(Pm[C_DZ + h * 128 + 64 + lane]));
    }
}

namespace attn {
using bf16x8=__attribute__((ext_vector_type(8)))short;
using s16x4=__attribute__((ext_vector_type(4)))short;
using f32x16=__attribute__((ext_vector_type(16)))float;
using u32x4=__attribute__((ext_vector_type(4)))unsigned;
constexpr int D=64,PITCH=NPROJ,NW=8,QBLK=32,QB=QBLK*NW,KVBLK=64;
__device__ __forceinline__ int crow(int r,int hi){return (r&3)+8*(r>>2)+4*hi;}
#define SBAR() __builtin_amdgcn_sched_barrier(0)
__device__ __forceinline__ void cmask(f32x16&p0,f32x16&p1,int jb,int qrel,int hi){
  const float NEG=-INFINITY; int kb=64*jb+4*hi;
  #pragma unroll
  for(int r=0;r<16;++r){int kv=kb+(r&3)+8*(r>>2); if(kv>qrel)p0[r]=NEG; if(kv+32>qrel)p1[r]=NEG;}
}
constexpr int TBN=448;
__device__ __forceinline__ void dbias(f32x16&p0,f32x16&p1,int jb,int wid,int qrel,int hi,const __attribute__((address_space(3))) float*tb){
  if(jb>(wid>>1)){
    #pragma unroll
    for(int r=0;r<16;++r){p0[r]=-INFINITY;p1[r]=-INFINITY;}
  } else {
    const __attribute__((address_space(3))) float*t0=tb+(64*jb+4*hi-qrel+383);
    #pragma unroll
    for(int r=0;r<16;++r){const int o=(r&3)+8*(r>>2); p0[r]+=t0[o]; p1[r]+=t0[o+32];}
  }
}
constexpr int NSLOT=3, SLOTB=10240;
constexpr int LDS_K=0, LDS_V=NSLOT*SLOTB, LDS_WS=2*NSLOT*SLOTB, LDS_OST=LDS_WS+NW*64*4, LDS_TB=LDS_OST+NW*4096, LDS_BYTES=LDS_TB+4*TBN*4;
__device__ __forceinline__ void glds16(const void*gsrc,unsigned lds_dst){unsigned keep;
  asm volatile("s_mov_b32 %0, m0\n\ts_mov_b32 m0, %2\n\ts_nop 0\n\tglobal_load_lds_dwordx4 %1, off\n\ts_mov_b32 m0, %0":"=&s"(keep):"v"(gsrc),"s"(lds_dst):"memory");}
__device__ __forceinline__ float max3f(float a,float b,float c){float r;asm("v_max3_f32 %0, %1, %2, %3":"=v"(r):"v"(a),"v"(b),"v"(c));return r;}
__device__ __forceinline__ float max2f(float a,float b){float r;asm("v_max_f32_e32 %0, %1, %2":"=v"(r):"v"(a),"v"(b));return r;}
__device__ __forceinline__ float fadd_s(float a,float b){float r;asm("v_add_f32_e32 %0, %1, %2":"=v"(r):"v"(a),"v"(b));return r;}
__device__ __forceinline__ float fsub_s(float a,float b){float r;asm("v_sub_f32_e32 %0, %1, %2":"=v"(r):"v"(a),"v"(b));return r;}
typedef float f32x2_t __attribute__((ext_vector_type(2))); typedef __bf16 bf16x2_t __attribute__((ext_vector_type(2)));
__device__ __forceinline__ unsigned cvtpk_s(float lo,float hi){f32x2_t v={lo,hi};bf16x2_t b=__builtin_convertvector(v,bf16x2_t);return __builtin_bit_cast(unsigned,b);}
#define WAIT_BAR(N) asm volatile("s_waitcnt vmcnt(" #N ") lgkmcnt(0)\n\ts_barrier":::"memory")
#define MF(a,b,c) __builtin_amdgcn_mfma_f32_32x32x16_bf16(a,b,c,0,0,0)
typedef __attribute__((address_space(3))) const char* lds_cptr;
typedef short v4i16_t __attribute__((ext_vector_type(4)));
#define LDSF(p) (*(const __attribute__((address_space(3))) bf16x8*)(p))
template<bool FOX> __device__ __forceinline__ void qkt(f32x16&p0,f32x16&p1,lds_cptr kp,lds_cptr kpx,const bf16x8*qr,const f32x16&negm){
  #pragma unroll
  for(int d0=0;d0<4;++d0){
    const bf16x8 b0=LDSF(kp+d0*2048), b1=LDSF(kp+d0*2048+512);
    if(d0==0){p0=MF(b0,qr[0],negm);p1=MF(b1,qr[0],negm);}
    else{p0=MF(b0,qr[d0],p0);p1=MF(b1,qr[d0],p1);}}
  if(FOX){ const bf16x8 b0=LDSF(kpx), b1=LDSF(kpx+512); p0=MF(b0,qr[4],p0); p1=MF(b1,qr[4],p1); }
}
template<bool FOX> __device__ __forceinline__ void kloadall(bf16x8*kf,lds_cptr kp,lds_cptr kpx){
  kf[0]=LDSF(kp);      kf[1]=LDSF(kp+512);  kf[2]=LDSF(kp+2048); kf[3]=LDSF(kp+2560);
  kf[4]=LDSF(kp+4096); kf[5]=LDSF(kp+4608); kf[6]=LDSF(kp+6144); kf[7]=LDSF(kp+6656);
  if(FOX){ kf[8]=LDSF(kpx); kf[9]=LDSF(kpx+512); }
}
__device__ __forceinline__ void kload2(bf16x8*kf,lds_cptr kp,int j){ kf[2*j]=LDSF(kp+j*2048); kf[2*j+1]=LDSF(kp+j*2048+512); }
__device__ __forceinline__ s16x4 vtr(lds_cptr p){ return __builtin_bit_cast(s16x4,__builtin_amdgcn_ds_read_tr16_b64_v4i16((__attribute__((address_space(3))) v4i16_t*)p)); }
__device__ __forceinline__ float rowmax(const f32x16&p0,const f32x16&p1){
  float a=max3f(p0[0],p0[1],p1[0]),b=max3f(p0[2],p0[3],p1[1]);a=max3f(a,p1[2],p1[3]);
  #pragma unroll
  for(int r=4;r<16;r+=4){a=max3f(a,p0[r],p0[r+1]);b=max3f(b,p0[r+2],p0[r+3]);a=max3f(a,p1[r],p1[r+1]);b=max3f(b,p1[r+2],p1[r+3]);}
  const float m=max2f(a,b);
  auto rr=__builtin_amdgcn_permlane32_swap(__float_as_uint(m),__float_as_uint(m),false,false);
  return max2f(__uint_as_float(rr[0]),__uint_as_float(rr[1]));
}
__device__ __forceinline__ void pv(f32x16*o,int vb,bf16x8 pa0,bf16x8 pa1,bf16x8 pa2,bf16x8 pa3){
  #pragma unroll
  for(int d0=0;d0<2;++d0){s16x4 lo[4],hi[4];
    #pragma unroll
    for(int ks=0;ks<4;++ks){
      asm volatile("ds_read_b64_tr_b16 %0,%1 offset:%c2":"=&v"(lo[ks]):"v"(vb),"i"(d0*4096+ks*1024):"memory");
      asm volatile("ds_read_b64_tr_b16 %0,%1 offset:%c2":"=&v"(hi[ks]):"v"(vb),"i"(d0*4096+ks*1024+512):"memory");}
    asm volatile("s_waitcnt lgkmcnt(0)":::"memory");SBAR();
    #define PK(k) (bf16x8){lo[k][0],lo[k][1],lo[k][2],lo[k][3],hi[k][0],hi[k][1],hi[k][2],hi[k][3]}
    o[d0]=MF(pa0,PK(0),o[d0]); o[d0]=MF(pa1,PK(1),o[d0]); o[d0]=MF(pa2,PK(2),o[d0]); o[d0]=MF(pa3,PK(3),o[d0]);
    #undef PK
  }
}
__device__ __forceinline__ unsigned mulbf2(unsigned a,unsigned b){ return cvtpk_s(bflo(a)*bflo(b),bfhi(a)*bfhi(b)); }

template<bool FOX,int THRL> __device__ __forceinline__ void attn_unit(int qb,const bf16*Qb,const bf16*__restrict__ Kb,const bf16*__restrict__ Vb,const bf16*QXb,const bf16*__restrict__ KXb,
                                                                      bf16*Ob,int opitch,const bf16*Gb,int head,char*shm){
  constexpr int NKF=FOX?10:8;
  int tid=threadIdx.x; asm volatile("":"+v"(tid));
  const int lane=tid&63,r32=lane&31,hi=lane>>5; const int wid=__builtin_amdgcn_readfirstlane(tid>>6);
  const int q0=qb*QB;
  const bf16*Qw=Qb+(long)(q0+wid*QBLK)*PITCH;
  const unsigned lds0=(unsigned)(uintptr_t)shm;
  float*wsf=(float*)(shm+LDS_WS)+wid*64;
  const bf16*ksrc=Kb+(long)lane*PITCH+wid*8;
  const bf16*vsrc=Vb+(long)(16*(wid&3)+(lane>>2))*PITCH+(wid>>2)*32+(lane&3)*8;
  const bf16*kxsrc=FOX?KXb+(long)lane*64:nullptr;
  const unsigned kdst=lds0+LDS_K+wid*1024, vdst=lds0+LDS_V+wid*1024, kxdst=lds0+LDS_K+8192;
  #define DMA_K(t,slot) do{ glds16(ksrc+(long)(t)*KVBLK*PITCH,(unsigned)__builtin_amdgcn_readfirstlane(kdst+(slot))); \
      if(FOX&&wid==0) glds16(kxsrc+(long)(t)*KVBLK*64,(unsigned)__builtin_amdgcn_readfirstlane(kxdst+(slot))); }while(0)
  #define DMA_V(t,slot) glds16(vsrc+(long)(t)*KVBLK*PITCH,(unsigned)__builtin_amdgcn_readfirstlane(vdst+(slot)))
  const int vb0=(int)(lds0+LDS_V)+((lane>>4)&1)*32+(lane&3)*8+(4*hi+((lane&15)>>2))*64;
  bf16x8 kf[NKF];
  const lds_cptr shm3=(lds_cptr)shm; const lds_cptr kp0=shm3+LDS_K+hi*1024+r32*16; const lds_cptr kpx0=shm3+LDS_K+8192+hi*1024+r32*16;
  const lds_cptr vp0=shm3+LDS_V+((lane>>4)&1)*32+(lane&3)*8+(4*hi+((lane&15)>>2))*64;
  const __attribute__((address_space(3))) float*tb=(const __attribute__((address_space(3))) float*)(shm3+LDS_TB)+head*TBN;
  const int NT=(q0+QB)/KVBLK;
  DMA_K(0,0);DMA_V(0,0);DMA_K(1,SLOTB);
  bf16x8 qr[FOX?5:4];
  #pragma unroll
  for(int d0=0;d0<4;++d0)qr[d0]=*reinterpret_cast<const bf16x8*>(&Qw[(long)r32*PITCH+d0*16+hi*8]);
  if(FOX){ bf16x8 qx=*reinterpret_cast<const bf16x8*>(QXb+(long)(q0+wid*QBLK+r32)*64); if(hi)qx=bf16x8{}; qr[FOX?4:0]=qx; }
  #define SETN() do{ if(FOX){ const float n_=-mhat; const unsigned nh_=f2bf(n_); const float r1_=n_-bf2f((unsigned short)nh_); const unsigned nm_=f2bf(r1_); const unsigned nl_=f2bf(r1_-bf2f((unsigned short)nm_)); \
      u32x4 q_=__builtin_bit_cast(u32x4,qr[FOX?4:0]); if(hi){ q_.x=nh_|(nm_<<16); q_.y=nl_; } qr[FOX?4:0]=__builtin_bit_cast(bf16x8,q_); } \
    else { _Pragma("unroll") for(int r=0;r<16;++r)negm[r]=-mhat; asm volatile("":"+v"(negm)); } }while(0)
  #define CINIT (FOX?f32x16{}:negm)
  float mhat=0.f,l_reg=0.f;f32x16 o[2];o[0]=f32x16{};o[1]=f32x16{};f32x16 negm=f32x16{};asm volatile("":"+v"(negm));
  const int qrel=wid*QBLK+r32;
  #define CMASK(P0,P1,t) do{int jb_=(t)-(NT-4); if(FOX){ if(jb_>=0)cmask(P0,P1,jb_,qrel,hi); } else { if(jb_>=-2)dbias(P0,P1,jb_,wid,qrel,hi,tb); } }while(0)
  bool resc=false;
  #define START(P0,P1) do{ const float rm=rowmax(P0,P1); resc=false; \
    { const float dl=rm; mhat=fadd_s(mhat,dl); \
      _Pragma("unroll") for(int r=0;r<16;++r){P0[r]=fsub_s(P0[r],dl);P1[r]=fsub_s(P1[r],dl);} \
      SETN(); } \
    _Pragma("unroll") for(int r=0;r<16;++r)P0[r]=__builtin_amdgcn_exp2f(P0[r]); }while(0)
  #define RESC() do{ if(resc){ asm volatile("s_waitcnt lgkmcnt(0)":::"memory"); \
      _Pragma("unroll") for(int d_=0;d_<2;++d_) _Pragma("unroll") for(int r=0;r<16;++r)o[d_][r]*=wsf[crow(r,hi)]; } }while(0)
  f32x16 pA0,pA1,pB0,pB1;
  int sl_prev=0,sl_cur=0,sl_next=SLOTB;
  #define ROT() do{sl_prev=sl_cur;sl_cur=sl_next;sl_next=(sl_next==(NSLOT-1)*SLOTB)?0:sl_next+SLOTB;}while(0)
  DMA_K(2,2*SLOTB);
  WAIT_BAR(3);
  qkt<FOX>(pA0,pA1,kp0,kpx0,qr,CINIT);asm volatile("s_nop 15\n\ts_nop 7":"+v"(pA0),"+v"(pA1));CMASK(pA0,pA1,0);
  START(pA0,pA1);
  _Pragma("unroll") for(int r=0;r<16;++r)pA1[r]=__builtin_amdgcn_exp2f(pA1[r]);
  WAIT_BAR(0);
  DMA_K(3,0);DMA_V(1,SLOTB);
  ROT();
  kloadall<FOX>(kf,kp0+sl_cur,kpx0+sl_cur);
  WAIT_BAR(2);
  s16x4 vlo[8],vhi[8]; u32x4 pw0,pw1,pw2,pw3;
  #define PKW(P,B) cvtpk_s(P[B],P[B+1])
  #define PAF(k) __builtin_bit_cast(bf16x8,pw##k)
  #define VFR(i) (bf16x8){vlo[i][0],vlo[i][1],vlo[i][2],vlo[i][3],vhi[i][0],vhi[i][1],vhi[i][2],vhi[i][3]}
  #define PIN(x) asm volatile("":"+v"(x))
  #define MX3(a,b,c) __builtin_fmaxf(__builtin_fmaxf((a),(b)),(c))
  #define GAPA(MFX,A0,A1,A2,A3,W0,W1,PW) do{ MFX; sacc+=A0; sacc+=A1; sacc+=A2; sacc+=A3; PIN(sacc); W0; W1; PIN(PW); SBAR(); }while(0)
  #define EX(v) __builtin_amdgcn_exp2f(v)
  #define GAPB(MFX,X,B) do{ MFX; X[B]=EX(X[B]); X[B+1]=EX(X[B+1]); X[B+2]=EX(X[B+2]); X[B+3]=EX(X[B+3]); PIN(X); SBAR(); }while(0)
  #define VRD(i) do{ vlo[i]=vtr(vp_+(((i)>>2)*4096+((i)&3)*1024)); vhi[i]=vtr(vp_+(((i)>>2)*4096+((i)&3)*1024+512)); }while(0)
  #define KRD(G,j) do{ if(G){ kload2(kf,kp0+sl_next,j); SBAR(); } }while(0)
  #define KRDX(G) do{ if(FOX&&(G)){ kf[NKF-2]=LDSF(kpx0+sl_next); kf[NKF-1]=LDSF(kpx0+sl_next+512); SBAR(); } }while(0)
  #define STEP(C0,C1,P0,P1,t,GK,GV,GL) do{ SBAR(); \
    const lds_cptr vp_=vp0+sl_prev; \
    VRD(0); SBAR(); float sacc=(P0[0]+P0[1]); \
    GAPA(C0=MF(kf[0],qr[0],CINIT), P0[2],P0[3],P0[4],P0[5],     pw0[0]=PKW(P0,0), pw0[1]=PKW(P0,2), pw0); \
    VRD(4); SBAR(); GAPA(C1=MF(kf[1],qr[0],CINIT), P0[6],P0[7],P0[8],P0[9],     pw0[2]=PKW(P0,4), pw0[3]=PKW(P0,6), pw0); \
    VRD(1); SBAR(); GAPA(C0=MF(kf[2],qr[1],C0),   P0[10],P0[11],P0[12],P0[13], pw1[0]=PKW(P0,8), pw1[1]=PKW(P0,10), pw1); \
    VRD(5); SBAR(); GAPA(C1=MF(kf[3],qr[1],C1),   P0[14],P0[15],P1[0],P1[1],   pw1[2]=PKW(P0,12),pw1[3]=PKW(P0,14), pw1); \
    VRD(2); SBAR(); GAPA(C0=MF(kf[4],qr[2],C0),   P1[2],P1[3],P1[4],P1[5],     pw2[0]=PKW(P1,0), pw2[1]=PKW(P1,2), pw2); \
    VRD(6); SBAR(); GAPA(C1=MF(kf[5],qr[2],C1),   P1[6],P1[7],P1[8],P1[9],     pw2[2]=PKW(P1,4), pw2[3]=PKW(P1,6), pw2); \
    VRD(3); SBAR(); GAPA(C0=MF(kf[6],qr[3],C0),   P1[10],P1[11],P1[12],P1[13], pw3[0]=PKW(P1,8), pw3[1]=PKW(P1,10), pw3); \
    VRD(7); SBAR(); GAPA(C1=MF(kf[7],qr[3],C1),   P1[14],P1[15],0.f,0.f,       pw3[2]=PKW(P1,12),pw3[3]=PKW(P1,14), pw3); \
    if(FOX){ C0=MF(kf[NKF-2],qr[FOX?4:0],C0); C1=MF(kf[NKF-1],qr[FOX?4:0],C1); SBAR(); } \
    l_reg+=sacc; \
    if(GK){DMA_K((t)+3,sl_cur);} if(GV){DMA_V((t)+1,sl_next);} \
    CMASK(C0,C1,t); \
    { float a=MX3(C0[0],C0[1],C1[0]),b=MX3(C0[2],C0[3],C1[1]); a=MX3(a,C1[2],C1[3]); \
      _Pragma("unroll") for(int r=4;r<16;r+=4){a=MX3(a,C0[r],C0[r+1]);b=MX3(b,C0[r+2],C0[r+3]);a=MX3(a,C1[r],C1[r+1]);b=MX3(b,C1[r+2],C1[r+3]);} \
      float rm=__builtin_fmaxf(a,b); { auto rr=__builtin_amdgcn_permlane32_swap(__float_as_uint(rm),__float_as_uint(rm),false,false); rm=__builtin_fmaxf(__uint_as_float(rr[0]),__uint_as_float(rr[1])); } \
      resc=false; \
      if(__builtin_expect(__any(rm>(float)THRL),0)){ const float dl=__builtin_fmaxf(rm,0.f); mhat+=dl; \
        _Pragma("unroll") for(int r=0;r<16;++r){C0[r]-=dl;C1[r]-=dl;} \
        SETN(); \
        const float f=__builtin_amdgcn_exp2f(-dl); l_reg*=f; if(hi==0)wsf[r32]=f; resc=true; } } \
    SBAR(); \
    GAPB(o[0]=MF(PAF(0),VFR(0),o[0]), C0,0); \
    GAPB(o[1]=MF(PAF(0),VFR(4),o[1]), C0,4); \
    KRD(GL,0); GAPB(o[0]=MF(PAF(1),VFR(1),o[0]), C0,8); \
    KRD(GL,1); GAPB(o[1]=MF(PAF(1),VFR(5),o[1]), C0,12); \
    KRD(GL,2); GAPB(o[0]=MF(PAF(2),VFR(2),o[0]), C1,0); \
    KRD(GL,3); GAPB(o[1]=MF(PAF(2),VFR(6),o[1]), C1,4); \
    KRDX(GL);  GAPB(o[0]=MF(PAF(3),VFR(3),o[0]), C1,8); \
    GAPB(o[1]=MF(PAF(3),VFR(7),o[1]), C1,12); \
    }while(0)
  int t=1;
  #undef CMASK
  #define CMASK(P0,P1,t) do{}while(0)
  for(;t+(FOX?5:7)<NT;t+=2){
    STEP(pB0,pB1,pA0,pA1,t,true,true,true);     WAIT_BAR(2); RESC(); ROT();
    STEP(pA0,pA1,pB0,pB1,t+1,true,true,true);   WAIT_BAR(2); RESC(); ROT();
  }
  #undef CMASK
  #define CMASK(P0,P1,t) do{int jb_=(t)-(NT-4); if(FOX){ if(jb_>=0)cmask(P0,P1,jb_,qrel,hi); } else { if(jb_>=-2)dbias(P0,P1,jb_,wid,qrel,hi,tb); } }while(0)
  #define ENDW(tt) do{ if((tt)+3<NT){WAIT_BAR(2);} else if((tt)+2<NT){WAIT_BAR(1);} else {WAIT_BAR(0);} }while(0)
  for(;t+1<NT;t+=2){
    STEP(pB0,pB1,pA0,pA1,t,(t+3<NT),(t+1<NT),(t+1<NT));       ENDW(t);   RESC(); ROT();
    STEP(pA0,pA1,pB0,pB1,t+1,(t+4<NT),(t+2<NT),(t+2<NT));     ENDW(t+1); RESC(); ROT();
  }
  STEP(pB0,pB1,pA0,pA1,NT-1,false,false,false); RESC();
  { float sacc=pB0[0]+pB0[1]; _Pragma("unroll") for(int r=2;r<16;++r)sacc+=pB0[r]; _Pragma("unroll") for(int r=0;r<16;++r)sacc+=pB1[r]; l_reg+=sacc;
    pw0=(u32x4){PKW(pB0,0),PKW(pB0,2),PKW(pB0,4),PKW(pB0,6)};pw1=(u32x4){PKW(pB0,8),PKW(pB0,10),PKW(pB0,12),PKW(pB0,14)};pw2=(u32x4){PKW(pB1,0),PKW(pB1,2),PKW(pB1,4),PKW(pB1,6)};pw3=(u32x4){PKW(pB1,8),PKW(pB1,10),PKW(pB1,12),PKW(pB1,14)};
    SBAR(); pv(o,vb0+sl_cur,PAF(0),PAF(1),PAF(2),PAF(3)); }
  #undef PKW
  #undef PAF
  #undef VFR
  #undef PIN
  #undef MX3
  #undef GAPA
  #undef GAPB
  #undef EX
  #undef VRD
  #undef KRD
  #undef KRDX
  #undef STEP
  #undef ENDW
  {auto rr=__builtin_amdgcn_permlane32_swap(__float_as_uint(l_reg),__float_as_uint(l_reg),false,false);l_reg=__uint_as_float(rr[0])+__uint_as_float(rr[1]);}
  if(hi==0)wsf[32+r32]=l_reg;asm volatile("s_waitcnt lgkmcnt(0)":::"memory");
  float rli[16];
  #pragma unroll
  for(int r=0;r<16;++r)rli[r]=__builtin_amdgcn_rcpf(wsf[32+crow(r,hi)]);
  bf16*Ow=Ob+(long)(q0+wid*QBLK)*opitch; const bf16*Gw=Gb?Gb+(long)(q0+wid*QBLK)*PITCH:nullptr;
  { bf16*stg=(bf16*)(shm+LDS_OST)+wid*2048;
    #pragma unroll
    for(int r=0;r<16;++r){const int orow=crow(r,hi);
      #pragma unroll
      for(int d0=0;d0<2;++d0)stg[orow*64+d0*32+r32]=(bf16)f2bf(o[d0][r]*rli[r]);}
    asm volatile("s_waitcnt lgkmcnt(0)":::"memory");
    #pragma unroll
    for(int i=0;i<4;++i){const int row=i*8+(lane>>3),ch=lane&7; u32x4 v=*(const u32x4*)(stg+row*64+ch*8);
      if(Gw){ const u32x4 g=*(const u32x4*)(Gw+(long)row*PITCH+ch*8); v.x=mulbf2(v.x,g.x); v.y=mulbf2(v.y,g.y); v.z=mulbf2(v.z,g.z); v.w=mulbf2(v.w,g.w); }
      *(u32x4*)(Ow+(long)row*opitch+ch*8)=v;} }
  asm volatile("s_waitcnt lgkmcnt(0)\n\ts_barrier":::"memory");
  #undef DMA_K
  #undef DMA_V
  #undef CMASK
  #undef START
  #undef RESC
  #undef ROT
  #undef SETN
  #undef CINIT
}
#undef SBAR
#undef WAIT_BAR
#undef MF
#undef LDSF
}

__device__ __forceinline__ void attn_prompt_phase(const Frame& F, char* shm) {
    const bf16* P = (const bf16*)(F.ws + WS_P); bf16* Y = (bf16*)(F.ws + WS_Y); bf16* OD = (bf16*)(F.ws + WS_XN);
    const bf16* QX = (const bf16*)(F.ws + WS_QX); const bf16* KX = (const bf16*)(F.ws + WS_KX);
    { LAS float* tb = (LAS float*)(F.lds + attn::LDS_TB); const float* relb = F.in[18];
      for (int i = F.tid; i < 4 * attn::TBN; i += 512) { const int h = i / attn::TBN, rel = i % attn::TBN - 383; tb[i] = (relb[t5_bucket(rel) * 4 + h] - relb[15 * 4 + h]) * LOG2E; }
      if (F.tid < 3 * 64) { const int sl = F.tid >> 6, row = F.tid & 63;
          *(LAS u32x4*)(F.lds + attn::LDS_K + sl * attn::SLOTB + 9216 + row * 16) = (u32x4){0x3F803F80u, 0x00003F80u, 0u, 0u}; }
      __syncthreads(); }
    const int G = gridDim.x, bx = blockIdx.x;
    const int nd = 32 * 16 * 4, nf = 64 * 16;
    if (G == 256) {
        const int vcu = (bx & 7) * 32 + (bx >> 3);
        { const int bh = vcu >> 3, b = bh >> 2, h = bh & 3, s = vcu & 7;
          for (int i = 0; i < 8; ++i) { const int qb = (i >> 2) ? 15 - s : s, mm = i & 1, vh = (i >> 1) & 1; const size_t rb = (size_t)b * TP;
              attn::attn_unit<false, 8>(qb, P + rb * NPROJ + C_DQ + h * 128 + mm * 64, P + rb * NPROJ + C_DK + h * 128 + mm * 64, P + rb * NPROJ + C_DV + h * 128 + vh * 64, nullptr, nullptr,
                                        OD + rb * DM + h * 256 + mm * 128 + vh * 64, DM, nullptr, h, shm); } }
        { const int st = vcu >> 2, b = st >> 3, h = st & 7;
          for (int i = 0; i < 4; ++i) { const int s = 2 * (vcu & 3) + (i >> 1), qb = (i & 1) ? 15 - s : s; const size_t rb = (size_t)b * TP;
              attn::attn_unit<true, 20>(qb, P + rb * NPROJ + C_FQ + h * 64, P + rb * NPROJ + C_FK + h * 64, P + rb * NPROJ + C_FV + h * 64, QX + rb * 64 + h * 8, KX + rb * 64 + h * 8,
                                        Y + rb * DM + h * 64, DM, P + rb * NPROJ + C_FZ + h * 64, 0, shm); } }
    } else {
        for (int u = bx; u < nd; u += G) { const int sub = u & 3, qb = (u >> 2) & 15, bh = u >> 6, b = bh >> 2, h = bh & 3, mm = sub & 1, vh = sub >> 1; const size_t rb = (size_t)b * TP;
            attn::attn_unit<false, 8>(qb, P + rb * NPROJ + C_DQ + h * 128 + mm * 64, P + rb * NPROJ + C_DK + h * 128 + mm * 64, P + rb * NPROJ + C_DV + h * 128 + vh * 64, nullptr, nullptr,
                                      OD + rb * DM + h * 256 + mm * 128 + vh * 64, DM, nullptr, h, shm); }
        for (int u = bx; u < nf; u += G) { const int qb = u & 15, st = u >> 4, b = st >> 3, h = st & 7; const size_t rb = (size_t)b * TP;
            attn::attn_unit<true, 20>(qb, P + rb * NPROJ + C_FQ + h * 64, P + rb * NPROJ + C_FK + h * 64, P + rb * NPROJ + C_FV + h * 64, QX + rb * 64 + h * 8, KX + rb * 64 + h * 8,
                                      Y + rb * DM + h * 64, DM, P + rb * NPROJ + C_FZ + h * 64, 0, shm); }
    }
}
__device__ __forceinline__ void diff_combine_phase(const Frame& F) {
    const bf16* P = (const bf16*)(F.ws + WS_P); bf16* Y = (bf16*)(F.ws + WS_Y); const bf16* OD = (const bf16*)(F.ws + WS_XN); const float* sg = F.in[14];
    const int lane = F.lane, h = lane >> 4, e0 = (lane & 15) * 8;
    const float lam = expf(wave_sum(F.in[10][lane] * F.in[11][lane])) - expf(wave_sum(F.in[12][lane] * F.in[13][lane])) + 0.2f;
    float g[8];
#pragma unroll
    for (int i = 0; i < 8; ++i) g[i] = sg[e0 + i] * 0.8f;
    for (int m = F.gw; m < MP; m += F.ngw) {
        const u32x4 a = *(const u32x4*)(OD + (size_t)m * DM + h * 256 + e0), b = *(const u32x4*)(OD + (size_t)m * DM + h * 256 + 128 + e0);
        const u32x4 z = *(const u32x4*)(P + (size_t)m * NPROJ + C_DZ + h * 128 + e0);
        float d[8]; d[0] = bflo(a.x) - lam * bflo(b.x); d[1] = bfhi(a.x) - lam * bfhi(b.x); d[2] = bflo(a.y) - lam * bflo(b.y); d[3] = bfhi(a.y) - lam * bfhi(b.y);
        d[4] = bflo(a.z) - lam * bflo(b.z); d[5] = bfhi(a.z) - lam * bfhi(b.z); d[6] = bflo(a.w) - lam * bflo(b.w); d[7] = bfhi(a.w) - lam * bfhi(b.w);
        float ss = 0.f;
#pragma unroll
        for (int i = 0; i < 8; ++i) ss += d[i] * d[i];
        ss += __shfl_xor(ss, 1); ss += __shfl_xor(ss, 2); ss += __shfl_xor(ss, 4); ss += __shfl_xor(ss, 8);
        const float r = 1.0f / sqrtf(ss * (1.f / 128.f) + NORM_EPS);
        u32x4 w; w.x = pk2(d[0] * r * g[0] * bflo(z.x), d[1] * r * g[1] * bfhi(z.x)); w.y = pk2(d[2] * r * g[2] * bflo(z.y), d[3] * r * g[3] * bfhi(z.y));
        w.z = pk2(d[4] * r * g[4] * bflo(z.z), d[5] * r * g[5] * bfhi(z.z)); w.w = pk2(d[6] * r * g[6] * bflo(z.w), d[7] * r * g[7] * bfhi(z.w));
        *(u32x4*)(Y + (size_t)m * DM + 512 + h * 128 + e0) = w;
    }
}

__device__ __forceinline__ void final_norm_phase(const Frame& F) {
    const float* gf = F.in[19];
    for (int m = F.gw; m < MT; m += F.ngw) {
        float* row = F.out + (size_t)m * DM; f32x4 v[4]; float ss = 0.f;
#pragma unroll
        for (int j = 0; j < 4; ++j) { v[j] = *(const f32x4*)(row + 4 * (F.lane + 64 * j)); ss += (v[j][0] * v[j][0] + v[j][1] * v[j][1]) + (v[j][2] * v[j][2] + v[j][3] * v[j][3]); }
        const float rstd = 1.0f / sqrtf(wave_sum(ss) * (1.f / DM) + NORM_EPS);
#pragma unroll
        for (int j = 0; j < 4; ++j) { const f32x4 g = *(const f32x4*)(gf + 4 * (F.lane + 64 * j)); *(f32x4*)(row + 4 * (F.lane + 64 * j)) = v[j] * rstd * g; }
    }
}

#ifndef MK_MULTI
#define MK_MULTI 0
#endif
__global__ void __launch_bounds__(512, 2) fwd_kernel(Params p) {
    extern __shared__ __attribute__((aligned(16))) unsigned char lds_raw[];
    cg::grid_group grid = cg::this_grid();
    Frame F; F.lds = (LAS unsigned char*)lds_raw; F.tid = threadIdx.x; F.lane = F.tid & 63; F.wave = __builtin_amdgcn_readfirstlane(F.tid >> 6);
    F.gw = blockIdx.x * 8 + F.wave; F.ngw = gridDim.x * 8; F.in = p.in; F.out = p.out; F.ws = p.ws;
    const int lo = p.ph_lo, hi = p.ph_hi;
#define IN(k) (lo <= (k) && (k) < hi)
#define SEAM(k) do { if (IN(k) && IN((k) + 1)) grid.sync(); } while (0)
    bf16* XN = (bf16*)(p.ws + WS_XN); bf16* Pb = (bf16*)(p.ws + WS_P); bf16* Y = (bf16*)(p.ws + WS_Y); bf16* T = (bf16*)(p.ws + WS_XN); bf16* MG = (bf16*)(p.ws + WS_MG);
    if (IN(0)) phase0(F);
    SEAM(0);
    if (IN(1)) {
        scan_phase(F);
        pg8::Gemm g{XN, (const bf16*)(p.ws + WS_WIN), MT, NPROJ, DM, DM, DM}; pg8::StaticOrder S; S.init(MT, NPROJ, (int)gridDim.x, (int)blockIdx.x);
        pg8::EpiProj E{Pb, p.out};
        pg8::gemm_phase<pg8::EpiProj, pg8::StaticOrder, true, true>(F.lds, g, S, E);
    }
    SEAM(1);
    if (IN(2)) { attn_naive_phase(F); if (!NAIVE_PROMPT) attn_prompt_phase(F, (char*)lds_raw); }
    SEAM(2);
    if (IN(3)) { if (!NAIVE_PROMPT) diff_combine_phase(F); }
    SEAM(3);
    if (IN(4)) {
        { pg8::Gemm g{Y, (const bf16*)(p.ws + WS_WF), MT, DM, 512, DM, 512}; pg8::StaticOrder S; S.init(MT, DM, (int)gridDim.x, (int)blockIdx.x);
          pg8::EpiT E{Pb, T}; pg8::gemm_phase<pg8::EpiT, pg8::StaticOrder, true, true>(F.lds, g, S, E); }
        { pg8::Gemm g{Y + 512, (const bf16*)(p.ws + WS_WD), MT, DM, 512, DM, 512}; pg8::StaticOrder S; S.init(MT, DM, (int)gridDim.x, (int)blockIdx.x);
          pg8::EpiMG E{Pb, T, MG}; pg8::gemm_phase<pg8::EpiMG, pg8::StaticOrder, true, true>(F.lds, g, S, E); }
    }
    SEAM(4);
    if (IN(5)) {
        pg8::Gemm g{MG, (const bf16*)(p.ws + WS_WO), MT, DM, DM, DM, DM}; pg8::StaticOrder S; S.init(MT, DM, (int)gridDim.x, (int)blockIdx.x);
        pg8::EpiOut E{p.in[0], p.in[1], p.out}; pg8::gemm_phase<pg8::EpiOut, pg8::StaticOrder, true, true>(F.lds, g, S, E);
    }
    SEAM(5);
    if (IN(6)) final_norm_phase(F);
#undef IN
#undef SEAM
}

extern "C" void kernel_launch(void* const* d_in, const int* in_sizes, int n_in, void* d_out, int out_size, void* d_ws, size_t ws_size, hipStream_t stream) {
    static int grid = 0;
    if (grid == 0) {
        if (n_in != 20 || (size_t)out_size != O_END || ws_size < WS_END) { fprintf(stderr, "kernel_launch: unexpected shapes (n_in %d out %d ws %zu)\n", n_in, out_size, ws_size); grid = -1; return; }
        int dev = 0, cus = 0, per_cu = 0;
        hipGetDevice(&dev); hipDeviceGetAttribute(&cus, hipDeviceAttributeMultiprocessorCount, dev);
        if (hipFuncSetAttribute((const void*)fwd_kernel, hipFuncAttributeMaxDynamicSharedMemorySize, LDS_BYTES) != hipSuccess) { fprintf(stderr, "kernel_launch: hipFuncSetAttribute failed\n"); grid = -1; return; }
        if (hipOccupancyMaxActiveBlocksPerMultiprocessor(&per_cu, (const void*)fwd_kernel, 512, LDS_BYTES) != hipSuccess || per_cu < 1) { fprintf(stderr, "kernel_launch: occupancy query failed (%d)\n", per_cu); per_cu = 1; }
        (void)hipGetLastError();
        grid = cus * 1;
        fprintf(stderr, "kernel_launch: cus %d per_cu %d grid %d\n", cus, per_cu, grid);
    }
    if (grid < 0) return;
    Params p{};
    for (int i = 0; i < 20; ++i) p.in[i] = (const float*)d_in[i];
    p.out = (float*)d_out; p.ws = (unsigned char*)d_ws;
#if MK_MULTI
    for (int ph = 0; ph < NPHASE; ++ph) { p.ph_lo = ph; p.ph_hi = ph + 1; hipLaunchKernelGGL(fwd_kernel, dim3(grid), dim3(512), LDS_BYTES, stream, p); }
#else
    p.ph_lo = 0; p.ph_hi = NPHASE;
    void* args[] = {&p};
    hipError_t e = hipLaunchCooperativeKernel((const void*)fwd_kernel, dim3(grid), dim3(512), args, LDS_BYTES, stream);
    if (e != hipSuccess) fprintf(stderr, "kernel_launch: cooperative launch failed: %s (grid %d)\n", hipGetErrorString(e), grid);
#endif
}
```

```cpp
#include <hip/hip_runtime.h>
#include <hip/hip_cooperative_groups.h>
#include <cstdio>
#include <cstdint>
#include <cmath>
namespace cg = cooperative_groups;

namespace pg8 {
#define PG8_LAS __attribute__((address_space(3)))
typedef unsigned short bf16_t;
typedef short bf16x8 __attribute__((ext_vector_type(8)));
typedef float f32x4 __attribute__((ext_vector_type(4)));
typedef unsigned u32x4 __attribute__((ext_vector_type(4)));
constexpr int BM = 256, BK = 64, HALF = 128, HTB = HALF * BK * 2  , STAGE_BYTES = 8 * HTB, NXCD = 8, WGM = 8;

__host__ __device__ __forceinline__ int lds_byte(int r, int c) { const int st = (r >> 4) * 2 + (c >> 5), rr = r & 15, cc = c & 31, ob = rr * 64 + cc * 2; return st * 1024 + (ob ^ (((ob >> 9) & 1) << 5)); }
__host__ __device__ __forceinline__ void stage_rc(int b, int& R, int& C) { const int st = b / 1024, sb = b % 1024, swz = sb ^ (((sb >> 9) & 1) << 5); R = (st >> 1) * 16 + swz / 64; C = (st & 1) * 32 + (swz % 64) / 2; }
__host__ __device__ __forceinline__ int perm32(int rho) { const int n = rho >> 4, i = rho & 15; return 8 * (i >> 2) + 4 * n + (i & 3); }

struct Unit { int pm, pn; };
struct Gemm { const bf16_t* A; const bf16_t* Bt; int M, N, K, lda, ldb; };

struct StaticOrder {
    int nM, nN, nwg, G, c;
    __host__ __device__ void init(int M, int N, int G_, int c_) { nM = M / BM; nN = N / BM; nwg = nM * nN; G = G_; c = c_; }
    __host__ __device__ bool next(int i, Unit& u) const {
        const long L = (long)i * G + c; if (L >= nwg) return false;
        int wgid = (int)L; { const int q = nwg / NXCD, r = nwg % NXCD, xcd = wgid % NXCD, off = wgid / NXCD; wgid = (xcd < r ? xcd * (q + 1) : r * (q + 1) + (xcd - r) * q) + off; }
        const int nig = WGM * nN, gid = wgid / nig, fm = gid * WGM, gsz = (nM - fm) < WGM ? (nM - fm) : WGM;
        u.pm = fm + ((wgid % nig) % gsz); u.pn = (wgid % nig) / gsz; return true;
    }
    __device__ __forceinline__ void a_ready(const Unit&) const {}
    __device__ __forceinline__ void done(const Unit&) const {}
};


template <class Epi, class Sched, bool ALIGN_EPI = false, bool SP2 = false>
__device__ __forceinline__ void gemm_phase(PG8_LAS unsigned char* lds, const Gemm g, const Sched& S, const Epi& E) {
    const int tid = threadIdx.x, wid = __builtin_amdgcn_readfirstlane(tid >> 6), lane = tid & 63, wr = wid >> 2, wc = wid & 3, fr = lane & 15, fq = lane >> 4;
    const int K = g.K, nt = K / BK;
    unsigned voffA[2], voffB[2];
#pragma unroll
    for (int i = 0; i < 2; ++i) { int R, C; stage_rc(tid * 16 + i * 8192, R, C); const int Rb = Epi::PERM ? ((R & ~31) + perm32(R & 31)) : R;
        voffA[i] = (unsigned)(R * g.lda + C) * 2u; voffB[i] = (unsigned)(Rb * g.ldb + C) * 2u; }
    const size_t kstep = (size_t)(BK * 2);
    const size_t hstepA = (size_t)HALF * g.lda * 2, hstepB = (size_t)HALF * g.ldb * 2;
    const size_t tstepA = 2 * hstepA, tstepB = 2 * hstepB;
    const unsigned ldsw = (unsigned)wid * 1024u;
    const int aoff = lds_byte(wr * 64 + fr, fq * 8), boff = lds_byte(wc * 32 + fr, fq * 8);
#define PG8_SA(b, h) (((b) * 2 + (h)) * HTB)
#define PG8_SB(b, h) ((4 + (b) * 2 + (h)) * HTB)
#define PG8_STAGE(bufoff, gbase, voff) do { _Pragma("unroll") for (int _i = 0; _i < 2; ++_i) \
        __builtin_amdgcn_global_load_lds((const unsigned*)((const char*)(gbase) + (voff)[_i]), (PG8_LAS unsigned*)(lds + (bufoff) + ldsw + _i * 8192), 16, 0, 0); } while (0)
#define PG8_LDA(dst, b, h) do { _Pragma("unroll") for (int m = 0; m < 4; ++m) _Pragma("unroll") for (int k = 0; k < 2; ++k) dst[m][k] = *(const PG8_LAS bf16x8*)(lds + PG8_SA(b, h) + aoff + m * 2048 + k * 1024); } while (0)
#define PG8_LDB(dst, b, h) do { _Pragma("unroll") for (int n = 0; n < 2; ++n) _Pragma("unroll") for (int k = 0; k < 2; ++k) dst[n][k] = *(const PG8_LAS bf16x8*)(lds + PG8_SB(b, h) + boff + n * 2048 + k * 1024); } while (0)
#define PG8_MMA(ai, bj, At, Bt) do { __builtin_amdgcn_s_setprio(1); _Pragma("unroll") for (int m = 0; m < 4; ++m) _Pragma("unroll") for (int n = 0; n < 2; ++n) _Pragma("unroll") for (int k = 0; k < 2; ++k) \
        acc[ai][bj][m][n] = __builtin_amdgcn_mfma_f32_16x16x32_bf16(Bt[n][k], At[m][k], acc[ai][bj][m][n], 0, 0, 0); __builtin_amdgcn_s_setprio(0); } while (0)
#define PG8_WAIT_V(n) asm volatile("s_waitcnt vmcnt(" #n ")" ::: "memory")
#define PG8_WAIT_L(n) asm volatile("s_waitcnt lgkmcnt(" #n ")" ::: "memory")
#define PG8_BAR __builtin_amdgcn_s_barrier()
#define PG8_SCHED __builtin_amdgcn_sched_barrier(0)
    Unit cur, nxt; int ui = 0;
    if (!S.next(0, cur)) return;
    f32x4 acc[2][2][4][2];
#pragma unroll
    for (int a = 0; a < 2; ++a)
#pragma unroll
        for (int b = 0; b < 2; ++b)
#pragma unroll
            for (int m = 0; m < 4; ++m)
#pragma unroll
                for (int n = 0; n < 2; ++n) acc[a][b][m][n] = (f32x4){0.f, 0.f, 0.f, 0.f};
    bf16x8 At[4][2], B0[2][2], B1[2][2];
    const char* cA = (const char*)g.A + (size_t)cur.pm * tstepA; const char* cB = (const char*)g.Bt + (size_t)cur.pn * tstepB;
    S.a_ready(cur);
    if constexpr (SP2) {
        PG8_STAGE(PG8_SB(0, 0), cB, voffB); PG8_STAGE(PG8_SB(0, 1), cB + hstepB, voffB); PG8_STAGE(PG8_SA(0, 0), cA, voffA); PG8_STAGE(PG8_SA(0, 1), cA + hstepA, voffA);
        if (wr == 1) PG8_BAR;
        PG8_WAIT_V(2); PG8_BAR;
        PG8_STAGE(PG8_SB(1, 0), cB + kstep, voffB); PG8_STAGE(PG8_SA(1, 0), cA + kstep, voffA); PG8_STAGE(PG8_SB(1, 1), cB + hstepB + kstep, voffB);
        PG8_WAIT_V(6); PG8_BAR;
    } else {
        PG8_STAGE(PG8_SB(0, 0), cB, voffB); PG8_STAGE(PG8_SA(0, 0), cA, voffA); PG8_STAGE(PG8_SB(0, 1), cB + hstepB, voffB); PG8_STAGE(PG8_SA(0, 1), cA + hstepA, voffA);
        if (wr == 1) PG8_BAR;
        PG8_WAIT_V(4); PG8_BAR;
        PG8_STAGE(PG8_SB(1, 0), cB + kstep, voffB); PG8_STAGE(PG8_SA(1, 0), cA + kstep, voffA); PG8_STAGE(PG8_SB(1, 1), cB + hstepB + kstep, voffB);
        PG8_WAIT_V(6); PG8_BAR;
    }
    for (;;) {
        const bool has_next = S.next(ui + 1, nxt);
        const char* nA = has_next ? (const char*)g.A + (size_t)nxt.pm * tstepA : cA; const char* nB = has_next ? (const char*)g.Bt + (size_t)nxt.pn * tstepB : cB;
        for (int t = 0; t < nt; t += 2) {
            const bool last = (t == nt - 2);
            const char* a1 = cA + (size_t)(t + 1) * kstep;
            const char* a2 = last ? nA : cA + (size_t)(t + 2) * kstep; const char* b2 = last ? nB : cB + (size_t)(t + 2) * kstep;
            const char* a3 = a2 + kstep; const char* b3 = b2 + kstep;
            if (last && has_next) S.a_ready(nxt);
            if constexpr (SP2) {
            PG8_LDB(B0, 0, 0); PG8_LDB(B1, 0, 1); PG8_SCHED; PG8_LDA(At, 0, 0); PG8_STAGE(PG8_SA(1, 1), a1 + hstepA, voffA);
            PG8_WAIT_V(8); PG8_WAIT_L(0); PG8_BAR; PG8_MMA(0, 0, At, B0); PG8_MMA(0, 1, At, B1); PG8_BAR; PG8_SCHED;
            PG8_LDA(At, 0, 1); PG8_STAGE(PG8_SB(0, 0), b2, voffB); PG8_STAGE(PG8_SB(0, 1), b2 + hstepB, voffB); PG8_STAGE(PG8_SA(0, 0), a2, voffA);
            PG8_WAIT_V(8); PG8_WAIT_L(0); PG8_BAR; PG8_MMA(1, 0, At, B0); PG8_MMA(1, 1, At, B1); PG8_BAR; PG8_SCHED;
            PG8_LDB(B0, 1, 0); PG8_LDB(B1, 1, 1); PG8_SCHED; PG8_LDA(At, 1, 0); PG8_STAGE(PG8_SA(0, 1), a2 + hstepA, voffA);
            PG8_WAIT_V(8); PG8_WAIT_L(0); PG8_BAR; PG8_MMA(0, 0, At, B0); PG8_MMA(0, 1, At, B1); PG8_BAR; PG8_SCHED;
            PG8_LDA(At, 1, 1); PG8_STAGE(PG8_SB(1, 0), b3, voffB); PG8_STAGE(PG8_SB(1, 1), b3 + hstepB, voffB); PG8_STAGE(PG8_SA(1, 0), a3, voffA);
            PG8_WAIT_V(8); PG8_WAIT_L(0); PG8_BAR; PG8_MMA(1, 0, At, B0); PG8_MMA(1, 1, At, B1); PG8_BAR; PG8_SCHED;
            } else {
            PG8_LDB(B0, 0, 0); PG8_SCHED; PG8_LDA(At, 0, 0); PG8_STAGE(PG8_SA(1, 1), a1 + hstepA, voffA);
            PG8_WAIT_L(8); PG8_BAR; PG8_WAIT_L(0); PG8_MMA(0, 0, At, B0); PG8_BAR; PG8_SCHED;
            PG8_LDB(B1, 0, 1); PG8_STAGE(PG8_SB(0, 0), b2, voffB);
            PG8_BAR; PG8_WAIT_L(0); PG8_MMA(0, 1, At, B1); PG8_BAR;
            PG8_LDA(At, 0, 1); PG8_STAGE(PG8_SA(0, 0), a2, voffA);
            PG8_BAR; PG8_WAIT_L(0); PG8_MMA(1, 0, At, B0); PG8_BAR; PG8_SCHED;
            PG8_STAGE(PG8_SB(0, 1), b2 + hstepB, voffB);
            PG8_WAIT_V(6); PG8_BAR; PG8_MMA(1, 1, At, B1); PG8_BAR;
            PG8_LDB(B0, 1, 0); PG8_SCHED; PG8_LDA(At, 1, 0); PG8_STAGE(PG8_SA(0, 1), a2 + hstepA, voffA);
            PG8_WAIT_L(8); PG8_BAR; PG8_WAIT_L(0); PG8_MMA(0, 0, At, B0); PG8_BAR; PG8_SCHED;
            PG8_LDB(B1, 1, 1); PG8_STAGE(PG8_SB(1, 0), b3, voffB);
            PG8_BAR; PG8_WAIT_L(0); PG8_MMA(0, 1, At, B1); PG8_BAR;
            PG8_LDA(At, 1, 1); PG8_STAGE(PG8_SA(1, 0), a3, voffA);
            PG8_BAR; PG8_WAIT_L(0); PG8_MMA(1, 0, At, B0); PG8_BAR; PG8_SCHED;
            PG8_STAGE(PG8_SB(1, 1), b3 + hstepB, voffB);
            PG8_WAIT_V(6); PG8_BAR; PG8_MMA(1, 1, At, B1); PG8_BAR;
            }
        }
        if constexpr (ALIGN_EPI) { if (wr == 0) PG8_BAR; }
        if constexpr (!Epi::AFTER_DRAIN) { E(acc, cur, wr, wc, fr, fq); S.done(cur); }
        if (!has_next) break;
#pragma unroll
        for (int a = 0; a < 2; ++a)
#pragma unroll
            for (int b = 0; b < 2; ++b)
#pragma unroll
                for (int m = 0; m < 4; ++m)
#pragma unroll
                    for (int n = 0; n < 2; ++n) acc[a][b][m][n] = (f32x4){0.f, 0.f, 0.f, 0.f};
        cur = nxt; cA = nA; cB = nB; ++ui;
        if constexpr (ALIGN_EPI) { if (wr == 1) PG8_BAR; }
    }
    PG8_WAIT_V(0);
    if constexpr (!ALIGN_EPI) { if (wr == 0) PG8_BAR; }
    PG8_BAR;
    if constexpr (Epi::AFTER_DRAIN) { E.fused(acc, cur, wr, wc, fr, fq, lds, wid, lane); S.done(cur); }
#undef PG8_SA
#undef PG8_SB
#undef PG8_STAGE
#undef PG8_LDA
#undef PG8_LDB
#undef PG8_MMA
#undef PG8_WAIT_V
#undef PG8_WAIT_L
#undef PG8_BAR
#undef PG8_SCHED
}
}


typedef unsigned short bf16;
typedef unsigned u32x4 __attribute__((ext_vector_type(4)));
typedef float f32x4 __attribute__((ext_vector_type(4)));
#define LAS __attribute__((address_space(3)))
constexpr int DM = 1024, MP = 32768, MS = 512, MT = MP + MS;
constexpr int TP = 4096, TS = 16, PAST = 2048, KS = PAST + TS;
constexpr int NPROJ = 6144, INW = 6152;
constexpr int C_FQ = 0, C_FK = 512, C_FV = 1024, C_FZ = 1536, C_DQ = 2048, C_DK = 2560, C_DV = 3072, C_DZ = 3584, C_GA = 4096, C_GB = 5120;
constexpr size_t O_YP = 0, O_YS = 33554432, O_FKP = 34078720, O_FVP = 50855936, O_FLP = 67633152, O_DKP = 67895296, O_DVP = 84672512,
                 O_FKS = 101449728, O_FVS = 101711872, O_FLS = 101974016, O_DKS = 101978112, O_DVS = 102240256, O_END = 102502400;
constexpr size_t MiB = 1u << 20;
constexpr size_t WS_CTL = 0, WS_WIN = 2 * MiB, WS_WF = 14 * MiB, WS_WD = 15 * MiB, WS_WO = 16 * MiB, WS_ST = 1 * MiB  , WS_LC = 18 * MiB  , WS_CUMP = 18 * MiB, WS_CUMS = 19 * MiB, WS_QX = 22 * MiB, WS_KX = 27 * MiB,
                 WS_XN = 32 * MiB  , WS_P = 98 * MiB  , WS_Y = 488 * MiB  , WS_MG = 554 * MiB  , WS_PART = WS_MG  , WS_END = 620 * MiB;
constexpr float LOG2E = 1.4426950408889634f, C2 = 0.125f * 1.4426950408889634f, NORM_EPS = 1e-6f;
constexpr int LDS_BYTES = 147456;
constexpr int NPHASE = 8;

struct Params { const float* in[20]; float* out; unsigned char* ws; int ph_lo, ph_hi; };

__device__ __forceinline__ unsigned f2bf(float f) { unsigned u = __builtin_bit_cast(unsigned, f); return (u + 0x7fffu + ((u >> 16) & 1u)) >> 16; }
__device__ __forceinline__ unsigned pk2(float lo, float hi) { return f2bf(lo) | (f2bf(hi) << 16); }
__device__ __forceinline__ float bf2f(unsigned short b) { return __uint_as_float((unsigned)b << 16); }
__device__ __forceinline__ float bflo(unsigned w) { return __uint_as_float(w << 16); }
__device__ __forceinline__ float bfhi(unsigned w) { return __uint_as_float(w & 0xffff0000u); }
__device__ __forceinline__ float wave_sum(float v) {
#pragma unroll
    for (int o = 1; o < 64; o <<= 1) v += __shfl_xor(v, o);
    return v;
}
__device__ __forceinline__ float wave_max(float v) {
#pragma unroll
    for (int o = 1; o < 64; o <<= 1) v = fmaxf(v, __shfl_xor(v, o));
    return v;
}
__device__ __forceinline__ float sigmoidf_(float z) { return __builtin_amdgcn_rcpf(1.f + __builtin_amdgcn_exp2f(-z * LOG2E)); }

namespace pg8 {
struct EpiProj {
    static constexpr bool PERM = true, AFTER_DRAIN = false;
    bf16_t* P; float* out;
    __device__ __forceinline__ void operator()(const f32x4 (&acc)[2][2][4][2], const Unit& u, int wr, int wc, int fr, int fq) const {
        const int colt = u.pn * BM, seg = colt >> 9;
        const bool samp = u.pm >= (MP / BM);
        int op; float* fo = nullptr;
        if (seg == 0 || seg == 4) op = 0; else if (seg == 3 || seg == 7) op = 2; else if (seg >= 8) op = 3;
        else { op = 1; const size_t ob = seg == 1 ? (samp ? O_FKS : O_FKP) : seg == 2 ? (samp ? O_FVS : O_FVP) : seg == 5 ? (samp ? O_DKS : O_DKP) : (samp ? O_DVS : O_DVP); fo = out + ob; }
        const int row0 = u.pm * BM + wr * 64 + fr, col0 = colt + wc * 32 + 8 * fq, scol0 = col0 - (seg << 9);
#pragma unroll
        for (int ai = 0; ai < 2; ++ai)
#pragma unroll
            for (int m = 0; m < 4; ++m) { const int r = row0 + ai * HALF + m * 16; bf16_t* rowp = P + (size_t)r * NPROJ + col0; const int rr = samp ? r - MP : r;
#pragma unroll
                for (int bj = 0; bj < 2; ++bj) { f32x4 v0 = acc[ai][bj][m][0], v1 = acc[ai][bj][m][1];
                    if (op == 1) { float* fp = fo + (size_t)rr * 512 + scol0 + bj * HALF; *(f32x4*)fp = v0; *(f32x4*)(fp + 4) = v1; }
                    else if (op == 0) { v0 = v0 * C2; v1 = v1 * C2; }
                    else {
#pragma unroll
                        for (int e = 0; e < 4; ++e) { const float s0 = sigmoidf_(v0[e]), s1 = sigmoidf_(v1[e]); v0[e] = op == 2 ? v0[e] * s0 : s0; v1[e] = op == 2 ? v1[e] * s1 : s1; } }
                    u32x4 w; w.x = pk2(v0[0], v0[1]); w.y = pk2(v0[2], v0[3]); w.z = pk2(v1[0], v1[1]); w.w = pk2(v1[2], v1[3]);
                    *(u32x4*)(rowp + bj * HALF) = w; } }
    }
};
struct EpiT {
    static constexpr bool PERM = true, AFTER_DRAIN = false;
    const bf16_t* P; bf16_t* T;
    __device__ __forceinline__ void operator()(const f32x4 (&acc)[2][2][4][2], const Unit& u, int wr, int wc, int fr, int fq) const {
        const int row0 = u.pm * BM + wr * 64 + fr, col0 = u.pn * BM + wc * 32 + 8 * fq;
#pragma unroll
        for (int ai = 0; ai < 2; ++ai)
#pragma unroll
            for (int m = 0; m < 4; ++m) { const int r = row0 + ai * HALF + m * 16;
#pragma unroll
                for (int bj = 0; bj < 2; ++bj) { const int c = col0 + bj * HALF; const f32x4 v0 = acc[ai][bj][m][0], v1 = acc[ai][bj][m][1];
                    const u32x4 g = *(const u32x4*)(P + (size_t)r * NPROJ + C_GA + c);
                    u32x4 w; w.x = pk2(v0[0] * bflo(g.x), v0[1] * bfhi(g.x)); w.y = pk2(v0[2] * bflo(g.y), v0[3] * bfhi(g.y)); w.z = pk2(v1[0] * bflo(g.z), v1[1] * bfhi(g.z)); w.w = pk2(v1[2] * bflo(g.w), v1[3] * bfhi(g.w));
                    *(u32x4*)(T + (size_t)r * DM + c) = w; } }
    }
};
struct EpiMG {
    static constexpr bool PERM = true, AFTER_DRAIN = false;
    const bf16_t* P; const bf16_t* T; bf16_t* MG;
    __device__ __forceinline__ void operator()(const f32x4 (&acc)[2][2][4][2], const Unit& u, int wr, int wc, int fr, int fq) const {
        const int row0 = u.pm * BM + wr * 64 + fr, col0 = u.pn * BM + wc * 32 + 8 * fq;
#pragma unroll
        for (int ai = 0; ai < 2; ++ai)
#pragma unroll
            for (int m = 0; m < 4; ++m) { const int r = row0 + ai * HALF + m * 16;
#pragma unroll
                for (int bj = 0; bj < 2; ++bj) { const int c = col0 + bj * HALF; const f32x4 v0 = acc[ai][bj][m][0], v1 = acc[ai][bj][m][1];
                    const u32x4 g = *(const u32x4*)(P + (size_t)r * NPROJ + C_GB + c); const u32x4 t = *(const u32x4*)(T + (size_t)r * DM + c);
                    u32x4 w; w.x = pk2(bflo(t.x) + v0[0] * bflo(g.x), bfhi(t.x) + v0[1] * bfhi(g.x)); w.y = pk2(bflo(t.y) + v0[2] * bflo(g.y), bfhi(t.y) + v0[3] * bfhi(g.y));
                    w.z = pk2(bflo(t.z) + v1[0] * bflo(g.z), bfhi(t.z) + v1[1] * bfhi(g.z)); w.w = pk2(bflo(t.w) + v1[2] * bflo(g.w), bfhi(t.w) + v1[3] * bfhi(g.w));
                    *(u32x4*)(MG + (size_t)r * DM + c) = w; } }
    }
};
struct EpiOut {
    static constexpr bool PERM = true, AFTER_DRAIN = false;
    const float* xp; const float* xs; float* out;
    __device__ __forceinline__ void operator()(const f32x4 (&acc)[2][2][4][2], const Unit& u, int wr, int wc, int fr, int fq) const {
        const int row0 = u.pm * BM + wr * 64 + fr, col0 = u.pn * BM + wc * 32 + 8 * fq;
        const bool samp = u.pm >= (MP / BM);
#pragma unroll
        for (int ai = 0; ai < 2; ++ai)
#pragma unroll
            for (int m = 0; m < 4; ++m) { const int r = row0 + ai * HALF + m * 16; const float* xr = samp ? xs + (size_t)(r - MP) * DM : xp + (size_t)r * DM;
#pragma unroll
                for (int bj = 0; bj < 2; ++bj) { const int c = col0 + bj * HALF;
                    const f32x4 x0 = *(const f32x4*)(xr + c), x1 = *(const f32x4*)(xr + c + 4);
                    *(f32x4*)(out + (size_t)r * DM + c) = x0 + acc[ai][bj][m][0]; *(f32x4*)(out + (size_t)r * DM + c + 4) = x1 + acc[ai][bj][m][1]; } }
    }
};
}


#define GAS __attribute__((address_space(1)))
#define XB_TMO      128
#define XB_XCNT(j)  (256  + 64 * (j))
#define XB_XSUB(j)  (1280 + 64 * (j))
#define XB_XGEN(j)  (2304 + 64 * (j))
#define XB_TOP      3328
#define XB_TOPGEN   3392
#define XCD_BAR_WORDS 3456
#define XB_SPIN_CAP (1u << 18)

__device__ __forceinline__ unsigned xb_ld(unsigned* p)              { return __hip_atomic_load(p, __ATOMIC_RELAXED, __HIP_MEMORY_SCOPE_AGENT); }
__device__ __forceinline__ unsigned xb_add(unsigned* p, unsigned v) { return __hip_atomic_fetch_add(p, v, __ATOMIC_RELAXED, __HIP_MEMORY_SCOPE_AGENT); }
__device__ __forceinline__ unsigned xb_xcc_id() { return (unsigned)__builtin_amdgcn_s_getreg((3 << 11) | 20) & 0xFu; }
#define XB_SPIN(cond, bar) do { unsigned _sp = 0; while (cond) { __builtin_amdgcn_s_sleep(1); \
    if ((++_sp & 255u) == 0u) { if (xb_ld(&(bar)[XB_TMO])) break; if (_sp > XB_SPIN_CAP) { atomicAdd(&(bar)[XB_TMO], 1u); break; } } } } while (0)

struct XcdBarrier {
    unsigned* bar; unsigned x;
    volatile LAS unsigned* st;
};

__device__ __forceinline__ XcdBarrier xcd_barrier_post(unsigned* bar, volatile LAS unsigned* st) {
    XcdBarrier b; b.bar = bar; b.x = xb_xcc_id(); b.st = st;
    if (threadIdx.x == 0) (void)xb_add(&bar[XB_XCNT(b.x)], 1u);
    return b;
}
__device__ __forceinline__ void xcd_barrier_complete(unsigned* bar, unsigned x, unsigned& nloc, unsigned& nx) {
    const unsigned G = gridDim.x * gridDim.y * gridDim.z;
    unsigned sum, cnt, mine, sp = 0u;
    for (;;) {
        sum = 0u; cnt = 0u; mine = 0u;
#pragma unroll
        for (unsigned j = 0; j < 16; ++j) { const unsigned c = xb_ld(&bar[XB_XCNT(j)]); sum += c; cnt += (c > 0u) ? 1u : 0u; mine = (j == x) ? c : mine; }
        if (sum == G) break;
        __builtin_amdgcn_s_sleep(1);
        if ((++sp & 255u) == 0u) { if (xb_ld(&bar[XB_TMO])) break; if (sp > XB_SPIN_CAP) { atomicAdd(&bar[XB_TMO], 1u); break; } }
    }
    nloc = mine > 0u ? mine : 1u; nx = cnt > 0u ? cnt : 1u;
}

__device__ __forceinline__ void xcd_barrier(const XcdBarrier& b) {
    asm volatile("s_waitcnt vmcnt(0)" ::: "memory");
    __syncthreads();
    if (threadIdx.x == 0) {
        unsigned* bar = b.bar;
        __builtin_amdgcn_s_waitcnt(0);
        unsigned nloc = b.st[0], nx = b.st[1];
        if (nloc == 0u) { xcd_barrier_complete(bar, b.x, nloc, nx); b.st[0] = nloc; b.st[1] = nx; }
        const unsigned old = xb_add(&bar[XB_XSUB(b.x)], 1u);
        const unsigned gen = old / nloc;
        if (old + 1u == (gen + 1u) * nloc) {
            __builtin_amdgcn_fence(__ATOMIC_RELEASE, "agent");
            asm volatile("s_waitcnt vmcnt(0)" ::: "memory");
            const unsigned og = xb_add(&bar[XB_TOP], 1u);
            const unsigned tg = og / nx;
            if (og + 1u == (tg + 1u) * nx) xb_add(&bar[XB_TOPGEN], 1u);
            else XB_SPIN(xb_ld(&bar[XB_TOPGEN]) == tg, bar);
            __builtin_amdgcn_fence(__ATOMIC_ACQUIRE, "agent");
            xb_add(&bar[XB_XGEN(b.x)], 1u);
            asm volatile("s_waitcnt vmcnt(0)" ::: "memory");
        } else {
            XB_SPIN(xb_ld(&bar[XB_XGEN(b.x)]) == gen, bar);
            __builtin_amdgcn_fence(__ATOMIC_ACQUIRE, "agent");
            asm volatile("s_waitcnt vmcnt(0)" ::: "memory");
        }
    }
    __syncthreads();
}

struct Frame {
    LAS unsigned char* lds; int tid, lane, wave, gw, ngw;
    const float* const* in; float* out; unsigned char* ws;
};

__device__ __forceinline__ void transpose_item(const float* W, int ldw, int c0, int k0, bf16* WT, int ldt, int n0, LAS float* scr, int lane) {
#pragma unroll 8
    for (int i = 0; i < 32; ++i) { const int kk = 2 * i + (lane >> 5); scr[kk * 33 + (lane & 31)] = W[(size_t)(k0 + kk) * ldw + c0 + (lane & 31)]; }
    asm volatile("s_waitcnt lgkmcnt(0)" ::: "memory");
    const int c = lane & 7;
#pragma unroll
    for (int j = 0; j < 4; ++j) { const int n = (lane >> 3) + 8 * j; const LAS float* s = scr + (8 * c) * 33 + n;
        u32x4 o; o.x = pk2(s[0 * 33], s[1 * 33]); o.y = pk2(s[2 * 33], s[3 * 33]); o.z = pk2(s[4 * 33], s[5 * 33]); o.w = pk2(s[6 * 33], s[7 * 33]);
        *(u32x4*)(WT + (size_t)(n0 + n) * ldt + k0 + 8 * c) = o; }
    asm volatile("s_waitcnt lgkmcnt(0)" ::: "memory");
}
__device__ __forceinline__ float log_sigmoid_f(float z) { return fminf(z, 0.f) - log1pf(expf(-fabsf(z))); }

__device__ __forceinline__ void phase0(const Frame& F) {
    const float* w_in = F.in[8]; const float* wuf = F.in[15]; const float* wud = F.in[16]; const float* wo = F.in[17];
    bf16* WIN = (bf16*)(F.ws + WS_WIN); bf16* WF = (bf16*)(F.ws + WS_WF); bf16* WD = (bf16*)(F.ws + WS_WD); bf16* WO = (bf16*)(F.ws + WS_WO);
    LAS float* scr = (LAS float*)(F.lds + F.wave * 16384);
    constexpr int I_IN = 16 * 192, I_UP = 8 * 32, I_O = 16 * 32, NITEMS = I_IN + 2 * I_UP + I_O;
    for (int it = F.gw; it < NITEMS; it += F.ngw) {
        int r = it;
        if (r < I_IN) { const int kb = r / 192, nb = r % 192, n0 = nb * 32; transpose_item(w_in, INW, n0 + (n0 >= 2048 ? 8 : 0), kb * 64, WIN, DM, n0, scr, F.lane); continue; } r -= I_IN;
        if (r < I_UP) { const int kb = r / 32, nb = r % 32; transpose_item(wuf, DM, nb * 32, kb * 64, WF, 512, nb * 32, scr, F.lane); continue; } r -= I_UP;
        if (r < I_UP) { const int kb = r / 32, nb = r % 32; transpose_item(wud, DM, nb * 32, kb * 64, WD, 512, nb * 32, scr, F.lane); continue; } r -= I_UP;
        { const int kb = r / 32, nb = r % 32; transpose_item(wo, DM, nb * 32, kb * 64, WO, DM, nb * 32, scr, F.lane); }
    }
    __syncthreads();
    LAS float* wgT = (LAS float*)F.lds; const float* gin = F.in[7];
    for (int i = F.tid; i < 8 * DM; i += 512) { const int j = i >> 10, k = i & 1023; wgT[i] = gin[k] * w_in[(size_t)k * INW + 2048 + j]; }
    __syncthreads();
    const float* xp = F.in[0]; const float* xs = F.in[1]; const float* bfg = F.in[9];
    bf16* XN = (bf16*)(F.ws + WS_XN);
    float* LC = (float*)(F.ws + WS_LC); float* ST = (float*)(F.ws + WS_ST);
    for (int seg = F.gw; seg < MP / 16 + MS; seg += F.ngw) {
        const bool pr = seg < MP / 16; const int m0 = pr ? seg * 16 : MP + (seg - MP / 16), nr = pr ? 16 : 1;
        float run = 0.f;
        for (int i = 0; i < nr; ++i) { const int m = m0 + i;
        const float* xrow = m < MP ? xp + (size_t)m * DM : xs + (size_t)(m - MP) * DM;
        f32x4 v[4]; float ss = 0.f;
#pragma unroll
        for (int j = 0; j < 4; ++j) { v[j] = *(const f32x4*)(xrow + 4 * (F.lane + 64 * j)); ss += (v[j][0] * v[j][0] + v[j][1] * v[j][1]) + (v[j][2] * v[j][2] + v[j][3] * v[j][3]); }
        const float rstd = 1.0f / sqrtf(wave_sum(ss) * (1.f / DM) + NORM_EPS);
        float fl[8];
#pragma unroll
        for (int jj = 0; jj < 8; ++jj) { float a = 0.f;
#pragma unroll
            for (int j = 0; j < 4; ++j) { const f32x4 w = *(const LAS f32x4*)(wgT + jj * DM + 4 * (F.lane + 64 * j)); a += (v[j][0] * w[0] + v[j][1] * w[1]) + (v[j][2] * w[2] + v[j][3] * w[3]); }
            fl[jj] = wave_sum(a) * rstd; }
        float mine = fl[0];
#pragma unroll
        for (int jj = 1; jj < 8; ++jj) mine = (F.lane == jj) ? fl[jj] : mine;
        if (F.lane < 8) { const float lf = log_sigmoid_f(mine + bfg[F.lane]);
            if (m < MP) { F.out[O_FLP + (size_t)m * 8 + F.lane] = lf; run += lf; LC[(size_t)m * 8 + F.lane] = run; } else F.out[O_FLS + (size_t)(m - MP) * 8 + F.lane] = lf; }
#pragma unroll
        for (int j = 0; j < 4; ++j) { const f32x4 g = *(const f32x4*)(gin + 4 * (F.lane + 64 * j));
            const unsigned lo = pk2(v[j][0] * rstd * g[0], v[j][1] * rstd * g[1]), hi = pk2(v[j][2] * rstd * g[2], v[j][3] * rstd * g[3]);
            *(unsigned long long*)(XN + (size_t)m * DM + 4 * (F.lane + 64 * j)) = (unsigned long long)lo | ((unsigned long long)hi << 32); }
        }
        if (pr && F.lane < 8) ST[(size_t)seg * 8 + F.lane] = run;
    }
}

__device__ __forceinline__ double wave_sum_d(double v) {
#pragma unroll
    for (int o = 1; o < 64; o <<= 1) v += __shfl_xor(v, o);
    return v;
}
__device__ __forceinline__ void scan_phase(const Frame& F) {
    const float* LC = (const float*)(F.ws + WS_LC); const float* ST = (const float*)(F.ws + WS_ST); float* cumS = (float*)(F.ws + WS_CUMS);
    const int lane = F.lane;
    for (int seg = F.gw; seg < MP / 16; seg += F.ngw) {
        const int b = seg >> 8, sidx = seg & 255;
        double acc[8];
#pragma unroll
        for (int h = 0; h < 8; ++h) acc[h] = 0.0;
#pragma unroll
        for (int k = 0; k < 4; ++k) { const int s = lane + 64 * k; if (s < sidx) { const f32x4 a = *(const f32x4*)(ST + (size_t)(b * 256 + s) * 8), c = *(const f32x4*)(ST + (size_t)(b * 256 + s) * 8 + 4);
                acc[0] += a[0]; acc[1] += a[1]; acc[2] += a[2]; acc[3] += a[3]; acc[4] += c[0]; acc[5] += c[1]; acc[6] += c[2]; acc[7] += c[3]; } }
        double pre = 0.0;
#pragma unroll
        for (int h = 0; h < 8; ++h) { const double t = wave_sum_d(acc[h]); pre = ((lane & 7) == h) ? t : pre; }
#pragma unroll
        for (int half = 0; half < 2; ++half) { const int row = seg * 16 + half * 8 + (lane >> 3), h = lane & 7;
            const double cd = pre + (double)LC[(size_t)row * 8 + h];
            const float c = (float)(cd * 1.4426950408889634);
            const unsigned ch = f2bf(c); const float r1 = c - bf2f((unsigned short)ch); const unsigned cm = f2bf(r1); const float r2 = r1 - bf2f((unsigned short)cm); const unsigned cl = f2bf(r2);
            const unsigned one = 0x3F80u;
            ((u32x4*)(F.ws + WS_QX))[(size_t)row * 8 + h] = (u32x4){ch | (cm << 16), cl | (one << 16), one | (one << 16), 0u};
            ((u32x4*)(F.ws + WS_KX))[(size_t)row * 8 + h] = (u32x4){one | (one << 16), one | ((ch ^ 0x8000u) << 16), (cm ^ 0x8000u) | ((cl ^ 0x8000u) << 16), 0u}; }
    }
    for (int it = F.gw; it < 32 * 32; it += F.ngw) {
        const int b = it >> 5, sg = it & 31; const float* past = F.in[4] + (size_t)b * PAST * 8;
        double acc[8];
#pragma unroll
        for (int h = 0; h < 8; ++h) acc[h] = 0.0;
        for (int s = 0; s < sg; ++s) { const f32x4 a = *(const f32x4*)(past + (size_t)(s * 64 + lane) * 8), c = *(const f32x4*)(past + (size_t)(s * 64 + lane) * 8 + 4);
            acc[0] += a[0]; acc[1] += a[1]; acc[2] += a[2]; acc[3] += a[3]; acc[4] += c[0]; acc[5] += c[1]; acc[6] += c[2]; acc[7] += c[3]; }
        const f32x4 a = *(const f32x4*)(past + (size_t)(sg * 64 + lane) * 8), c = *(const f32x4*)(past + (size_t)(sg * 64 + lane) * 8 + 4);
        double v[8] = {a[0], a[1], a[2], a[3], c[0], c[1], c[2], c[3]};
#pragma unroll
        for (int h = 0; h < 8; ++h) { double inc = v[h];
#pragma unroll
            for (int o = 1; o < 64; o <<= 1) { const double t = __shfl_up(inc, o); if (lane >= o) inc += t; }
            v[h] = inc + wave_sum_d(acc[h]);
            cumS[(size_t)(b * 8 + h) * KS + sg * 64 + lane] = (float)v[h]; }
        if (sg == 31) {
            const float* nw = F.out + O_FLS + (size_t)b * TS * 8;
#pragma unroll
            for (int h = 0; h < 8; ++h) { const double tot = __shfl(v[h], 63); double inc = lane < TS ? (double)nw[(size_t)lane * 8 + h] : 0.0;
#pragma unroll
                for (int o = 1; o < 16; o <<= 1) { const double t = __shfl_up(inc, o); if (lane >= o) inc += t; }
                if (lane < TS) cumS[(size_t)(b * 8 + h) * KS + PAST + lane] = (float)(tot + inc); }
        }
    }
}

__device__ __forceinline__ int t5_bucket(int rel) {
    const int n = rel < 0 ? -rel : rel; int b;
    if (n < 8) b = n; else if (n < 12) b = 8; else if (n < 16) b = 9; else if (n < 23) b = 10; else if (n < 32) b = 11; else if (n < 46) b = 12; else if (n < 64) b = 13; else if (n < 91) b = 14; else b = 15;
    return (rel > 0 ? 16 : 0) + b;
}
#if NAIVE_SAMPLE
struct QVec { float q[64]; };
__device__ __forceinline__ void load_q(QVec& Q, const bf16* p) {
#pragma unroll
    for (int c = 0; c < 8; ++c) { const u32x4 w = *(const u32x4*)(p + 8 * c);
        Q.q[8 * c + 0] = bflo(w.x); Q.q[8 * c + 1] = bfhi(w.x); Q.q[8 * c + 2] = bflo(w.y); Q.q[8 * c + 3] = bfhi(w.y); Q.q[8 * c + 4] = bflo(w.z); Q.q[8 * c + 5] = bfhi(w.z); Q.q[8 * c + 6] = bflo(w.w); Q.q[8 * c + 7] = bfhi(w.w); }
}
__device__ __forceinline__ float dot_bf16(const QVec& Q, const bf16* p) {
    float s = 0.f;
#pragma unroll
    for (int c = 0; c < 8; ++c) { const u32x4 w = *(const u32x4*)(p + 8 * c);
        s += Q.q[8 * c + 0] * bflo(w.x); s += Q.q[8 * c + 1] * bfhi(w.x); s += Q.q[8 * c + 2] * bflo(w.y); s += Q.q[8 * c + 3] * bfhi(w.y);
        s += Q.q[8 * c + 4] * bflo(w.z); s += Q.q[8 * c + 5] * bfhi(w.z); s += Q.q[8 * c + 6] * bflo(w.w); s += Q.q[8 * c + 7] * bfhi(w.w); }
    return s;
}
__device__ __forceinline__ float dot_f32(const QVec& Q, const float* p) {
    float s = 0.f;
#pragma unroll
    for (int c = 0; c < 16; ++c) { const f32x4 w = *(const f32x4*)(p + 4 * c); s += Q.q[4 * c] * w[0]; s += Q.q[4 * c + 1] * w[1]; s += Q.q[4 * c + 2] * w[2]; s += Q.q[4 * c + 3] * w[3]; }
    return s;
}
template <int NE, class Score, class Val>
__device__ __forceinline__ void naive_attn(int nkeys, Score score, Val val, float (&o)[NE], int lane) {
    float m = -INFINITY, l = 0.f;
#pragma unroll
    for (int e = 0; e < NE; ++e) o[e] = 0.f;
    for (int j0 = 0; j0 < nkeys; j0 += 64) {
        const int j = j0 + lane; const bool valid = j < nkeys;
        float s = -INFINITY; if (valid) s = score(j);
        const float mn = fmaxf(m, wave_max(s));
        const float alpha = exp2f(m - mn), pj = valid ? exp2f(s - mn) : 0.f;
        l = l * alpha + wave_sum(pj);
#pragma unroll
        for (int e = 0; e < NE; ++e) o[e] *= alpha;
        const int nj = (nkeys - j0) < 64 ? (nkeys - j0) : 64;
        for (int jj = 0; jj < nj; ++jj) { const float pb = __shfl(pj, jj);
#pragma unroll
            for (int e = 0; e < NE; ++e) o[e] += pb * val(j0 + jj, e); }
        m = mn;
    }
    const float il = 1.f / l;
#pragma unroll
    for (int e = 0; e < NE; ++e) o[e] *= il;
}
#ifndef NAIVE_PROMPT
#define NAIVE_PROMPT 0
#endif
#ifndef NAIVE_SAMPLE
#define NAIVE_SAMPLE 0
#endif
__device__ __forceinline__ void attn_naive_phase(const Frame& F) {
    const bf16* P = (const bf16*)(F.ws + WS_P); bf16* Y = (bf16*)(F.ws + WS_Y);
    const float* cumP = (const float*)(F.ws + WS_CUMP); const float* cumS = (const float*)(F.ws + WS_CUMS);
    const float* cfk = F.in[2]; const float* cfv = F.in[3]; const float* cdk = F.in[5]; const float* cdv = F.in[6];
    const float* tbl = F.in[18]; const float* sg = F.in[14];
    const int lane = F.lane;
    const float lam = expf(wave_sum(F.in[10][lane] * F.in[11][lane])) - expf(wave_sum(F.in[12][lane] * F.in[13][lane])) + 0.2f;
    for (int it = F.gw; it < (NAIVE_PROMPT ? MP * 8 : 0); it += F.ngw) {
        const int h = it & 7, m = it >> 3, b = m >> 12, t = m & 4095;
        const bf16* Pm = P + (size_t)m * NPROJ; const bf16* Pb = P + (size_t)(b * TP) * NPROJ;
        QVec Q; load_q(Q, Pm + C_FQ + h * 64);
        const float* cum = cumP + (size_t)(b * 8 + h) * TP; const float cq = cum[t];
        float o[1];
        naive_attn<1>(t + 1, [&](int j) { return dot_bf16(Q, Pb + (size_t)j * NPROJ + C_FK + h * 64) + (cq - cum[j]) * LOG2E; },
                      [&](int j, int e) { return bf2f(Pb[(size_t)j * NPROJ + C_FV + h * 64 + lane]); }, o, lane);
        Y[(size_t)m * DM + h * 64 + lane] = (bf16)f2bf(o[0] * bf2f(Pm[C_FZ + h * 64 + lane]));
    }
    for (int it = F.gw; it < MS * 8; it += F.ngw) {
        const int h = it & 7, ms = it >> 3, b = ms >> 4, t = ms & 15, m = MP + ms;
        const bf16* Pm = P + (size_t)m * NPROJ; const bf16* Pn = P + (size_t)(MP + b * TS) * NPROJ;
        QVec Q; load_q(Q, Pm + C_FQ + h * 64);
        const float* cum = cumS + (size_t)(b * 8 + h) * KS; const float cq = cum[PAST + t];
        const float* kb = cfk + ((size_t)b * PAST * 8 + h) * 64; const float* vb = cfv + ((size_t)b * PAST * 8 + h) * 64;
        float o[1];
        naive_attn<1>(PAST + t + 1, [&](int j) { return (j < PAST ? dot_f32(Q, kb + (size_t)j * 512) : dot_bf16(Q, Pn + (size_t)(j - PAST) * NPROJ + C_FK + h * 64)) + (cq - cum[j]) * LOG2E; },
                      [&](int j, int e) { return j < PAST ? vb[(size_t)j * 512 + lane] : bf2f(Pn[(size_t)(j - PAST) * NPROJ + C_FV + h * 64 + lane]); }, o, lane);
        Y[(size_t)m * DM + h * 64 + lane] = (bf16)f2bf(o[0] * bf2f(Pm[C_FZ + h * 64 + lane]));
    }
    for (int it = F.gw + (NAIVE_PROMPT ? 0 : MP * 4); it < (MP + MS) * 4; it += F.ngw) {
        const int h = it & 3, m = it >> 2; const bool samp = m >= MP;
        const int b = samp ? (m - MP) >> 4 : m >> 12, t = samp ? (m - MP) & 15 : m & 4095;
        const bf16* Pm = P + (size_t)m * NPROJ; const bf16* Pb = samp ? P + (size_t)(MP + b * TS) * NPROJ : P + (size_t)(b * TP) * NPROJ;
        const int qpos = samp ? PAST + t : t, nkeys = samp ? KS : ((t >> 6) + 1) * 64;
        const float* kb = cdk + ((size_t)b * PAST * 4 + h) * 128; const float* vb = cdv + ((size_t)b * PAST * 4 + h) * 128;
        float oo[2][2];
#pragma unroll
        for (int mm = 0; mm < 2; ++mm) {
            QVec Q; load_q(Q, Pm + C_DQ + h * 128 + mm * 64);
            if (samp) naive_attn<2>(nkeys, [&](int j) { return (j < PAST ? dot_f32(Q, kb + (size_t)j * 512 + mm * 64) : dot_bf16(Q, Pb + (size_t)(j - PAST) * NPROJ + C_DK + h * 128 + mm * 64)) + tbl[t5_bucket(j - qpos) * 4 + h] * LOG2E; },
                                    [&](int j, int e) { return j < PAST ? vb[(size_t)j * 512 + e * 64 + lane] : bf2f(Pb[(size_t)(j - PAST) * NPROJ + C_DV + h * 128 + e * 64 + lane]); }, oo[mm], lane);
            else naive_attn<2>(nkeys, [&](int j) { return dot_bf16(Q, Pb + (size_t)j * NPROJ + C_DK + h * 128 + mm * 64) + tbl[t5_bucket(j - qpos) * 4 + h] * LOG2E; },
                               [&](int j, int e) { return bf2f(Pb[(size_t)j * NPROJ + C_DV + h * 128 + e * 64 + lane]); }, oo[mm], lane);
        }
        const float d0 = oo[0][0] - lam * oo[1][0], d1 = oo[0][1] - lam * oo[1][1];
        const float r = 1.0f / sqrtf(wave_sum(d0 * d0 + d1 * d1) * (1.f / 128.f) + NORM_EPS);
        Y[(size_t)m * DM + 512 + h * 128 + lane] = (bf16)f2bf(d0 * r * sg[lane] * 0.8f * bf2f(Pm[C_DZ + h * 128 + lane]));
        Y[(size_t)m * DM + 512 + h * 128 + 64 + lane] = (bf16)f2bf(d1 * r * sg[64 + lane] * 0.8f * bf2f(Pm[C_DZ + h * 128 + 64 + lane]));
    }
}

#endif
namespace attn {
using bf16x8=__attribute__((ext_vector_type(8)))short;
using s16x4=__attribute__((ext_vector_type(4)))short;
using f32x16=__attribute__((ext_vector_type(16)))float;
using u32x4=__attribute__((ext_vector_type(4)))unsigned;
constexpr int D=64,PITCH=NPROJ,NW=8,QBLK=32,QB=QBLK*NW,KVBLK=64;
__device__ __forceinline__ int crow(int r,int hi){return (r&3)+8*(r>>2)+4*hi;}
#define SBAR() __builtin_amdgcn_sched_barrier(0)
__device__ __forceinline__ void cmask(f32x16&p0,f32x16&p1,int jb,int qrel,int hi){
  const float NEG=-INFINITY; int kb=64*jb+4*hi;
  #pragma unroll
  for(int r=0;r<16;++r){int kv=kb+(r&3)+8*(r>>2); if(kv>qrel)p0[r]=NEG; if(kv+32>qrel)p1[r]=NEG;}
}
constexpr int TBN=448;
__device__ __forceinline__ void dbias(f32x16&p0,f32x16&p1,int jb,int wid,int qrel,int hi,const __attribute__((address_space(3))) float*tb){
  if(jb>(wid>>1)){
    #pragma unroll
    for(int r=0;r<16;++r){p0[r]=-INFINITY;p1[r]=-INFINITY;}
  } else {
    const __attribute__((address_space(3))) float*t0=tb+(64*jb+4*hi-qrel+383);
    #pragma unroll
    for(int r=0;r<16;++r){const int o=(r&3)+8*(r>>2); p0[r]+=t0[o]; p1[r]+=t0[o+32];}
  }
}
constexpr int NSLOT=3, SLOTB=10240;
constexpr int LDS_K=0, LDS_V=NSLOT*SLOTB, LDS_WS=2*NSLOT*SLOTB, LDS_OST=LDS_WS+NW*64*4, LDS_TB=LDS_OST+NW*4096, LDS_BYTES=LDS_TB+4*TBN*4;
__device__ __forceinline__ void glds16(const void*gsrc,unsigned lds_dst){unsigned keep;
  asm volatile("s_mov_b32 %0, m0\n\ts_mov_b32 m0, %2\n\ts_nop 0\n\tglobal_load_lds_dwordx4 %1, off\n\ts_mov_b32 m0, %0":"=&s"(keep):"v"(gsrc),"s"(lds_dst):"memory");}
__device__ __forceinline__ float max3f(float a,float b,float c){float r;asm("v_max3_f32 %0, %1, %2, %3":"=v"(r):"v"(a),"v"(b),"v"(c));return r;}
__device__ __forceinline__ float max2f(float a,float b){float r;asm("v_max_f32_e32 %0, %1, %2":"=v"(r):"v"(a),"v"(b));return r;}
__device__ __forceinline__ float fadd_s(float a,float b){float r;asm("v_add_f32_e32 %0, %1, %2":"=v"(r):"v"(a),"v"(b));return r;}
__device__ __forceinline__ float fsub_s(float a,float b){float r;asm("v_sub_f32_e32 %0, %1, %2":"=v"(r):"v"(a),"v"(b));return r;}
typedef float f32x2_t __attribute__((ext_vector_type(2))); typedef __bf16 bf16x2_t __attribute__((ext_vector_type(2)));
__device__ __forceinline__ unsigned cvtpk_s(float lo,float hi){f32x2_t v={lo,hi};bf16x2_t b=__builtin_convertvector(v,bf16x2_t);return __builtin_bit_cast(unsigned,b);}
#define WAIT_BAR(N) asm volatile("s_waitcnt vmcnt(" #N ") lgkmcnt(0)\n\ts_barrier":::"memory")
#define MF(a,b,c) __builtin_amdgcn_mfma_f32_32x32x16_bf16(a,b,c,0,0,0)
typedef __attribute__((address_space(3))) const char* lds_cptr;
typedef short v4i16_t __attribute__((ext_vector_type(4)));
#define LDSF(p) (*(const __attribute__((address_space(3))) bf16x8*)(p))
template<bool FOX> __device__ __forceinline__ void qkt(f32x16&p0,f32x16&p1,lds_cptr kp,lds_cptr kpx,const bf16x8*qr,const f32x16&negm){
  #pragma unroll
  for(int d0=0;d0<4;++d0){
    const bf16x8 b0=LDSF(kp+d0*2048), b1=LDSF(kp+d0*2048+512);
    if(d0==0){p0=MF(b0,qr[0],negm);p1=MF(b1,qr[0],negm);}
    else{p0=MF(b0,qr[d0],p0);p1=MF(b1,qr[d0],p1);}}
  if(FOX){ const bf16x8 b0=LDSF(kpx), b1=LDSF(kpx+512); p0=MF(b0,qr[4],p0); p1=MF(b1,qr[4],p1); }
}
template<bool FOX> __device__ __forceinline__ void kloadall(bf16x8*kf,lds_cptr kp,lds_cptr kpx){
  kf[0]=LDSF(kp);      kf[1]=LDSF(kp+512);  kf[2]=LDSF(kp+2048); kf[3]=LDSF(kp+2560);
  kf[4]=LDSF(kp+4096); kf[5]=LDSF(kp+4608); kf[6]=LDSF(kp+6144); kf[7]=LDSF(kp+6656);
  if(FOX){ kf[8]=LDSF(kpx); kf[9]=LDSF(kpx+512); }
}
__device__ __forceinline__ void kload2(bf16x8*kf,lds_cptr kp,int j){ kf[2*j]=LDSF(kp+j*2048); kf[2*j+1]=LDSF(kp+j*2048+512); }
__device__ __forceinline__ s16x4 vtr(lds_cptr p){ return __builtin_bit_cast(s16x4,__builtin_amdgcn_ds_read_tr16_b64_v4i16((__attribute__((address_space(3))) v4i16_t*)p)); }
__device__ __forceinline__ float rowmax(const f32x16&p0,const f32x16&p1){
  float a=max3f(p0[0],p0[1],p1[0]),b=max3f(p0[2],p0[3],p1[1]);a=max3f(a,p1[2],p1[3]);
  #pragma unroll
  for(int r=4;r<16;r+=4){a=max3f(a,p0[r],p0[r+1]);b=max3f(b,p0[r+2],p0[r+3]);a=max3f(a,p1[r],p1[r+1]);b=max3f(b,p1[r+2],p1[r+3]);}
  const float m=max2f(a,b);
  auto rr=__builtin_amdgcn_permlane32_swap(__float_as_uint(m),__float_as_uint(m),false,false);
  return max2f(__uint_as_float(rr[0]),__uint_as_float(rr[1]));
}
__device__ __forceinline__ void pv(f32x16*o,int vb,bf16x8 pa0,bf16x8 pa1,bf16x8 pa2,bf16x8 pa3){
  #pragma unroll
  for(int d0=0;d0<2;++d0){s16x4 lo[4],hi[4];
    #pragma unroll
    for(int ks=0;ks<4;++ks){
      asm volatile("ds_read_b64_tr_b16 %0,%1 offset:%c2":"=&v"(lo[ks]):"v"(vb),"i"(d0*4096+ks*1024):"memory");
      asm volatile("ds_read_b64_tr_b16 %0,%1 offset:%c2":"=&v"(hi[ks]):"v"(vb),"i"(d0*4096+ks*1024+512):"memory");}
    asm volatile("s_waitcnt lgkmcnt(0)":::"memory");SBAR();
    #define PK(k) (bf16x8){lo[k][0],lo[k][1],lo[k][2],lo[k][3],hi[k][0],hi[k][1],hi[k][2],hi[k][3]}
    o[d0]=MF(pa0,PK(0),o[d0]); o[d0]=MF(pa1,PK(1),o[d0]); o[d0]=MF(pa2,PK(2),o[d0]); o[d0]=MF(pa3,PK(3),o[d0]);
    #undef PK
  }
}
__device__ __forceinline__ unsigned mulbf2(unsigned a,unsigned b){ return cvtpk_s(bflo(a)*bflo(b),bfhi(a)*bfhi(b)); }

template<bool FOX,int THRL> __device__ __forceinline__ void attn_unit(int qb,const bf16*Qb,const bf16*__restrict__ Kb,const bf16*__restrict__ Vb,const bf16*QXb,const bf16*__restrict__ KXb,
                                                                      bf16*Ob,int opitch,const bf16*Gb,int head,char*shm){
  constexpr int NKF=FOX?10:8;
  int tid=threadIdx.x; asm volatile("":"+v"(tid));
  const int lane=tid&63,r32=lane&31,hi=lane>>5; const int wid=__builtin_amdgcn_readfirstlane(tid>>6);
  const int q0=qb*QB;
  const bf16*Qw=Qb+(long)(q0+wid*QBLK)*PITCH;
  const unsigned lds0=(unsigned)(uintptr_t)shm;
  float*wsf=(float*)(shm+LDS_WS)+wid*64;
  const bf16*ksrc=Kb+(long)lane*PITCH+wid*8;
  const bf16*vsrc=Vb+(long)(16*(wid&3)+(lane>>2))*PITCH+(wid>>2)*32+(lane&3)*8;
  const bf16*kxsrc=FOX?KXb+(long)lane*64:nullptr;
  const unsigned kdst=lds0+LDS_K+wid*1024, vdst=lds0+LDS_V+wid*1024, kxdst=lds0+LDS_K+8192;
  #define DMA_K(t,slot) do{ glds16(ksrc+(long)(t)*KVBLK*PITCH,(unsigned)__builtin_amdgcn_readfirstlane(kdst+(slot))); \
      if(FOX&&wid==0) glds16(kxsrc+(long)(t)*KVBLK*64,(unsigned)__builtin_amdgcn_readfirstlane(kxdst+(slot))); }while(0)
  #define DMA_V(t,slot) glds16(vsrc+(long)(t)*KVBLK*PITCH,(unsigned)__builtin_amdgcn_readfirstlane(vdst+(slot)))
  const int vb0=(int)(lds0+LDS_V)+((lane>>4)&1)*32+(lane&3)*8+(4*hi+((lane&15)>>2))*64;
  bf16x8 kf[NKF];
  const lds_cptr shm3=(lds_cptr)shm; const lds_cptr kp0=shm3+LDS_K+hi*1024+r32*16; const lds_cptr kpx0=shm3+LDS_K+8192+hi*1024+r32*16;
  const lds_cptr vp0=shm3+LDS_V+((lane>>4)&1)*32+(lane&3)*8+(4*hi+((lane&15)>>2))*64;
  const __attribute__((address_space(3))) float*tb=(const __attribute__((address_space(3))) float*)(shm3+LDS_TB)+head*TBN;
  const int NT=(q0+QB)/KVBLK;
  DMA_K(0,0);DMA_V(0,0);DMA_K(1,SLOTB);
  bf16x8 qr[FOX?5:4];
  #pragma unroll
  for(int d0=0;d0<4;++d0)qr[d0]=*reinterpret_cast<const bf16x8*>(&Qw[(long)r32*PITCH+d0*16+hi*8]);
  if(FOX){ bf16x8 qx=*reinterpret_cast<const bf16x8*>(QXb+(long)(q0+wid*QBLK+r32)*64); if(hi)qx=bf16x8{}; qr[FOX?4:0]=qx; }
  #define SETN() do{ if(FOX){ const float n_=-mhat; const unsigned nh_=f2bf(n_); const float r1_=n_-bf2f((unsigned short)nh_); const unsigned nm_=f2bf(r1_); const unsigned nl_=f2bf(r1_-bf2f((unsigned short)nm_)); \
      u32x4 q_=__builtin_bit_cast(u32x4,qr[FOX?4:0]); if(hi){ q_.x=nh_|(nm_<<16); q_.y=nl_; } qr[FOX?4:0]=__builtin_bit_cast(bf16x8,q_); } \
    else { _Pragma("unroll") for(int r=0;r<16;++r)negm[r]=-mhat; asm volatile("":"+v"(negm)); } }while(0)
  #define CINIT (FOX?f32x16{}:negm)
  float mhat=0.f,l_reg=0.f;f32x16 o[2];o[0]=f32x16{};o[1]=f32x16{};f32x16 negm=f32x16{};asm volatile("":"+v"(negm));
  const int qrel=wid*QBLK+r32;
  #define CMASK(P0,P1,t) do{int jb_=(t)-(NT-4); if(FOX){ if(jb_>=0)cmask(P0,P1,jb_,qrel,hi); } else { if(jb_>=-2)dbias(P0,P1,jb_,wid,qrel,hi,tb); } }while(0)
  bool resc=false;
  #define START(P0,P1) do{ const float rm=rowmax(P0,P1); resc=false; \
    { const float dl=rm; mhat=fadd_s(mhat,dl); \
      _Pragma("unroll") for(int r=0;r<16;++r){P0[r]=fsub_s(P0[r],dl);P1[r]=fsub_s(P1[r],dl);} \
      SETN(); } \
    _Pragma("unroll") for(int r=0;r<16;++r)P0[r]=__builtin_amdgcn_exp2f(P0[r]); }while(0)
  #define RESC() do{ if(resc){ asm volatile("s_waitcnt lgkmcnt(0)":::"memory"); \
      _Pragma("unroll") for(int d_=0;d_<2;++d_) _Pragma("unroll") for(int r=0;r<16;++r)o[d_][r]*=wsf[crow(r,hi)]; } }while(0)
  f32x16 pA0,pA1,pB0,pB1;
  int sl_prev=0,sl_cur=0,sl_next=SLOTB;
  #define ROT() do{sl_prev=sl_cur;sl_cur=sl_next;sl_next=(sl_next==(NSLOT-1)*SLOTB)?0:sl_next+SLOTB;}while(0)
  DMA_K(2,2*SLOTB);
  WAIT_BAR(3);
  qkt<FOX>(pA0,pA1,kp0,kpx0,qr,CINIT);asm volatile("s_nop 15\n\ts_nop 7":"+v"(pA0),"+v"(pA1));CMASK(pA0,pA1,0);
  START(pA0,pA1);
  _Pragma("unroll") for(int r=0;r<16;++r)pA1[r]=__builtin_amdgcn_exp2f(pA1[r]);
  WAIT_BAR(0);
  DMA_K(3,0);DMA_V(1,SLOTB);
  ROT();
  kloadall<FOX>(kf,kp0+sl_cur,kpx0+sl_cur);
  WAIT_BAR(2);
  s16x4 vlo[8],vhi[8]; u32x4 pw0,pw1,pw2,pw3;
  #define PKW(P,B) cvtpk_s(P[B],P[B+1])
  #define PAF(k) __builtin_bit_cast(bf16x8,pw##k)
  #define VFR(i) (bf16x8){vlo[i][0],vlo[i][1],vlo[i][2],vlo[i][3],vhi[i][0],vhi[i][1],vhi[i][2],vhi[i][3]}
  #define PIN(x) asm volatile("":"+v"(x))
  #define MX3(a,b,c) __builtin_fmaxf(__builtin_fmaxf((a),(b)),(c))
  #define GAPA(MFX,A0,A1,A2,A3,W0,W1,PW) do{ MFX; sacc+=A0; sacc+=A1; sacc+=A2; sacc+=A3; PIN(sacc); W0; W1; PIN(PW); SBAR(); }while(0)
  #define EX(v) __builtin_amdgcn_exp2f(v)
  #define GAPB(MFX,X,B) do{ MFX; X[B]=EX(X[B]); X[B+1]=EX(X[B+1]); X[B+2]=EX(X[B+2]); X[B+3]=EX(X[B+3]); PIN(X); SBAR(); }while(0)
  #define VRD(i) do{ vlo[i]=vtr(vp_+(((i)>>2)*4096+((i)&3)*1024)); vhi[i]=vtr(vp_+(((i)>>2)*4096+((i)&3)*1024+512)); }while(0)
  #define KRD(G,j) do{ if(G){ kload2(kf,kp0+sl_next,j); SBAR(); } }while(0)
  #define KRDX(G) do{ if(FOX&&(G)){ kf[NKF-2]=LDSF(kpx0+sl_next); kf[NKF-1]=LDSF(kpx0+sl_next+512); SBAR(); } }while(0)
  #define STEP(C0,C1,P0,P1,t,GK,GV,GL) do{ SBAR(); \
    const lds_cptr vp_=vp0+sl_prev; \
    VRD(0); SBAR(); float sacc=(P0[0]+P0[1]); \
    GAPA(C0=MF(kf[0],qr[0],CINIT), P0[2],P0[3],P0[4],P0[5],     pw0[0]=PKW(P0,0), pw0[1]=PKW(P0,2), pw0); \
    VRD(4); SBAR(); GAPA(C1=MF(kf[1],qr[0],CINIT), P0[6],P0[7],P0[8],P0[9],     pw0[2]=PKW(P0,4), pw0[3]=PKW(P0,6), pw0); \
    VRD(1); SBAR(); GAPA(C0=MF(kf[2],qr[1],C0),   P0[10],P0[11],P0[12],P0[13], pw1[0]=PKW(P0,8), pw1[1]=PKW(P0,10), pw1); \
    VRD(5); SBAR(); GAPA(C1=MF(kf[3],qr[1],C1),   P0[14],P0[15],P1[0],P1[1],   pw1[2]=PKW(P0,12),pw1[3]=PKW(P0,14), pw1); \
    VRD(2); SBAR(); GAPA(C0=MF(kf[4],qr[2],C0),   P1[2],P1[3],P1[4],P1[5],     pw2[0]=PKW(P1,0), pw2[1]=PKW(P1,2), pw2); \
    VRD(6); SBAR(); GAPA(C1=MF(kf[5],qr[2],C1),   P1[6],P1[7],P1[8],P1[9],     pw2[2]=PKW(P1,4), pw2[3]=PKW(P1,6), pw2); \
    VRD(3); SBAR(); GAPA(C0=MF(kf[6],qr[3],C0),   P1[10],P1[11],P1[12],P1[13], pw3[0]=PKW(P1,8), pw3[1]=PKW(P1,10), pw3); \
    VRD(7); SBAR(); GAPA(C1=MF(kf[7],qr[3],C1),   P1[14],P1[15],0.f,0.f,       pw3[2]=PKW(P1,12),pw3[3]=PKW(P1,14), pw3); \
    if(FOX){ C0=MF(kf[NKF-2],qr[FOX?4:0],C0); C1=MF(kf[NKF-1],qr[FOX?4:0],C1); SBAR(); } \
    l_reg+=sacc; \
    if(GK){DMA_K((t)+3,sl_cur);} if(GV){DMA_V((t)+1,sl_next);} \
    CMASK(C0,C1,t); \
    { float a=MX3(C0[0],C0[1],C1[0]),b=MX3(C0[2],C0[3],C1[1]); a=MX3(a,C1[2],C1[3]); \
      _Pragma("unroll") for(int r=4;r<16;r+=4){a=MX3(a,C0[r],C0[r+1]);b=MX3(b,C0[r+2],C0[r+3]);a=MX3(a,C1[r],C1[r+1]);b=MX3(b,C1[r+2],C1[r+3]);} \
      float rm=__builtin_fmaxf(a,b); { auto rr=__builtin_amdgcn_permlane32_swap(__float_as_uint(rm),__float_as_uint(rm),false,false); rm=__builtin_fmaxf(__uint_as_float(rr[0]),__uint_as_float(rr[1])); } \
      resc=false; \
      if(__builtin_expect(__any(rm>(float)THRL),0)){ const float dl=__builtin_fmaxf(rm,0.f); mhat+=dl; \
        _Pragma("unroll") for(int r=0;r<16;++r){C0[r]-=dl;C1[r]-=dl;} \
        SETN(); \
        const float f=__builtin_amdgcn_exp2f(-dl); l_reg*=f; if(hi==0)wsf[r32]=f; resc=true; } } \
    SBAR(); \
    GAPB(o[0]=MF(PAF(0),VFR(0),o[0]), C0,0); \
    GAPB(o[1]=MF(PAF(0),VFR(4),o[1]), C0,4); \
    KRD(GL,0); GAPB(o[0]=MF(PAF(1),VFR(1),o[0]), C0,8); \
    KRD(GL,1); GAPB(o[1]=MF(PAF(1),VFR(5),o[1]), C0,12); \
    KRD(GL,2); GAPB(o[0]=MF(PAF(2),VFR(2),o[0]), C1,0); \
    KRD(GL,3); GAPB(o[1]=MF(PAF(2),VFR(6),o[1]), C1,4); \
    KRDX(GL);  GAPB(o[0]=MF(PAF(3),VFR(3),o[0]), C1,8); \
    GAPB(o[1]=MF(PAF(3),VFR(7),o[1]), C1,12); \
    }while(0)
  int t=1;
  #undef CMASK
  #define CMASK(P0,P1,t) do{}while(0)
  for(;t+(FOX?5:7)<NT;t+=2){
    STEP(pB0,pB1,pA0,pA1,t,true,true,true);     WAIT_BAR(2); RESC(); ROT();
    STEP(pA0,pA1,pB0,pB1,t+1,true,true,true);   WAIT_BAR(2); RESC(); ROT();
  }
  #undef CMASK
  #define CMASK(P0,P1,t) do{int jb_=(t)-(NT-4); if(FOX){ if(jb_>=0)cmask(P0,P1,jb_,qrel,hi); } else { if(jb_>=-2)dbias(P0,P1,jb_,wid,qrel,hi,tb); } }while(0)
  #define ENDW(tt) do{ if((tt)+3<NT){WAIT_BAR(2);} else if((tt)+2<NT){WAIT_BAR(1);} else {WAIT_BAR(0);} }while(0)
  for(;t+1<NT;t+=2){
    STEP(pB0,pB1,pA0,pA1,t,(t+3<NT),(t+1<NT),(t+1<NT));       ENDW(t);   RESC(); ROT();
    STEP(pA0,pA1,pB0,pB1,t+1,(t+4<NT),(t+2<NT),(t+2<NT));     ENDW(t+1); RESC(); ROT();
  }
  STEP(pB0,pB1,pA0,pA1,NT-1,false,false,false); RESC();
  { float sacc=pB0[0]+pB0[1]; _Pragma("unroll") for(int r=2;r<16;++r)sacc+=pB0[r]; _Pragma("unroll") for(int r=0;r<16;++r)sacc+=pB1[r]; l_reg+=sacc;
    pw0=(u32x4){PKW(pB0,0),PKW(pB0,2),PKW(pB0,4),PKW(pB0,6)};pw1=(u32x4){PKW(pB0,8),PKW(pB0,10),PKW(pB0,12),PKW(pB0,14)};pw2=(u32x4){PKW(pB1,0),PKW(pB1,2),PKW(pB1,4),PKW(pB1,6)};pw3=(u32x4){PKW(pB1,8),PKW(pB1,10),PKW(pB1,12),PKW(pB1,14)};
    SBAR(); pv(o,vb0+sl_cur,PAF(0),PAF(1),PAF(2),PAF(3)); }
  #undef PKW
  #undef PAF
  #undef VFR
  #undef PIN
  #undef MX3
  #undef GAPA
  #undef GAPB
  #undef EX
  #undef VRD
  #undef KRD
  #undef KRDX
  #undef STEP
  #undef ENDW
  {auto rr=__builtin_amdgcn_permlane32_swap(__float_as_uint(l_reg),__float_as_uint(l_reg),false,false);l_reg=__uint_as_float(rr[0])+__uint_as_float(rr[1]);}
  if(hi==0)wsf[32+r32]=l_reg;asm volatile("s_waitcnt lgkmcnt(0)":::"memory");
  float rli[16];
  #pragma unroll
  for(int r=0;r<16;++r)rli[r]=__builtin_amdgcn_rcpf(wsf[32+crow(r,hi)]);
  bf16*Ow=Ob+(long)(q0+wid*QBLK)*opitch; const bf16*Gw=Gb?Gb+(long)(q0+wid*QBLK)*PITCH:nullptr;
  { bf16*stg=(bf16*)(shm+LDS_OST)+wid*2048;
    #pragma unroll
    for(int r=0;r<16;++r){const int orow=crow(r,hi);
      #pragma unroll
      for(int d0=0;d0<2;++d0)stg[orow*64+d0*32+r32]=(bf16)f2bf(o[d0][r]*rli[r]);}
    asm volatile("s_waitcnt lgkmcnt(0)":::"memory");
    #pragma unroll
    for(int i=0;i<4;++i){const int row=i*8+(lane>>3),ch=lane&7; u32x4 v=*(const u32x4*)(stg+row*64+ch*8);
      if(Gw){ const u32x4 g=*(const u32x4*)(Gw+(long)row*PITCH+ch*8); v.x=mulbf2(v.x,g.x); v.y=mulbf2(v.y,g.y); v.z=mulbf2(v.z,g.z); v.w=mulbf2(v.w,g.w); }
      *(u32x4*)(Ow+(long)row*opitch+ch*8)=v;} }
  asm volatile("s_waitcnt lgkmcnt(0)\n\ts_barrier":::"memory");
  #undef DMA_K
  #undef DMA_V
  #undef CMASK
  #undef START
  #undef RESC
  #undef ROT
  #undef SETN
  #undef CINIT
}
#undef SBAR
#undef WAIT_BAR
#undef MF
#undef LDSF
}

namespace samp {
using bf16x8=__attribute__((ext_vector_type(8)))short;
using s16x4=__attribute__((ext_vector_type(4)))short;
typedef short v4i16_t __attribute__((ext_vector_type(4)));
typedef __attribute__((address_space(3))) const char* lds_cptr;
constexpr int NCH=16, CHK=128, WLDS=9216, VROW_F=144, VROW_D=272;
constexpr size_t PF_O=0, PF_M=(size_t)32*8*NCH*16*64*4, PF_L=PF_M+(size_t)32*8*NCH*16*4, PD_O=PF_L+(size_t)32*8*NCH*16*4,
                 PD_M=PD_O+(size_t)32*4*NCH*2*16*128*4, PD_L=PD_M+(size_t)32*4*NCH*2*16*4, PART_BYTES=PD_L+(size_t)32*4*NCH*2*16*4;
#define MF16(a,b,c) __builtin_amdgcn_mfma_f32_16x16x32_bf16(a,b,c,0,0,0)
__device__ __forceinline__ bf16x8 cvt8(const f32x4&a,const f32x4&b){ u32x4 w; w.x=attn::cvtpk_s(a[0],a[1]); w.y=attn::cvtpk_s(a[2],a[3]); w.z=attn::cvtpk_s(b[0],b[1]); w.w=attn::cvtpk_s(b[2],b[3]); return __builtin_bit_cast(bf16x8,w); }
__device__ __forceinline__ s16x4 vtr(lds_cptr p){ return __builtin_bit_cast(s16x4,__builtin_amdgcn_ds_read_tr16_b64_v4i16((__attribute__((address_space(3))) v4i16_t*)p)); }
__device__ __forceinline__ bf16x8 pk8(const s16x4&lo,const s16x4&hi){ return (bf16x8){lo[0],lo[1],lo[2],lo[3],hi[0],hi[1],hi[2],hi[3]}; }
__device__ __forceinline__ float max4(const f32x4&v){ return fmaxf(fmaxf(v[0],v[1]),fmaxf(v[2],v[3])); }
__device__ __forceinline__ void chunk_softmax(f32x4 (&S)[9],float&m,float&l,bf16x8 (&pf)[5]){
  float mx=max4(S[0]);
  #pragma unroll
  for(int k=1;k<9;++k)mx=fmaxf(mx,max4(S[k]));
  mx=fmaxf(mx,__shfl_xor(mx,16)); mx=fmaxf(mx,__shfl_xor(mx,32)); m=mx;
  float s=0.f;
  #pragma unroll
  for(int k=0;k<9;++k){
    #pragma unroll
    for(int r=0;r<4;++r){ S[k][r]=__builtin_amdgcn_exp2f(S[k][r]-mx); s+=S[k][r]; } }
  s+=__shfl_xor(s,16); s+=__shfl_xor(s,32); l=s;
  #pragma unroll
  for(int G=0;G<4;++G)pf[G]=cvt8(S[2*G],S[2*G+1]);
  pf[4]=cvt8(S[8],(f32x4){0.f,0.f,0.f,0.f});
}
__device__ __forceinline__ void fox_item(const Frame&F,int b,int h,int c,LAS unsigned char*wl){
  const int lane=F.lane,i16=lane&15,g=lane>>4; const bool last=(c==NCH-1); const int j0=c*CHK;
  const bf16*Pn=(const bf16*)(F.ws+WS_P)+(size_t)(MP+b*TS)*NPROJ; const float*cfk=F.in[2]; const float*cfv=F.in[3];
  const float*cum=(const float*)(F.ws+WS_CUMS)+(size_t)(b*8+h)*KS;
  bf16x8 qf[2];
  #pragma unroll
  for(int s=0;s<2;++s)qf[s]=*(const bf16x8*)(Pn+(size_t)i16*NPROJ+C_FQ+h*64+32*s+8*g);
  const float cq=cum[PAST+i16];
  f32x4 S[9];
  #pragma unroll
  for(int kb=0;kb<8;++kb){ const float*kr=cfk+((size_t)(b*PAST+j0+16*kb+i16)*8+h)*64+8*g;
    const f32x4 a0=*(const f32x4*)kr,a1=*(const f32x4*)(kr+4),a2=*(const f32x4*)(kr+32),a3=*(const f32x4*)(kr+36);
    f32x4 acc=MF16(cvt8(a0,a1),qf[0],((f32x4){0.f,0.f,0.f,0.f})); acc=MF16(cvt8(a2,a3),qf[1],acc);
    const f32x4 ck=*(const f32x4*)(cum+j0+16*kb+4*g);
    S[kb]=acc+(cq-ck)*LOG2E; }
  if(last){ const bf16*kr=Pn+(size_t)i16*NPROJ+C_FK+h*64+8*g;
    f32x4 acc=MF16(*(const bf16x8*)kr,qf[0],((f32x4){0.f,0.f,0.f,0.f})); acc=MF16(*(const bf16x8*)(kr+32),qf[1],acc);
    const f32x4 ck=*(const f32x4*)(cum+PAST+4*g); acc=acc+(cq-ck)*LOG2E;
    #pragma unroll
    for(int r=0;r<4;++r)if(4*g+r>i16)acc[r]=-INFINITY;
    S[8]=acc; }
  else S[8]=(f32x4){-INFINITY,-INFINITY,-INFINITY,-INFINITY};
  float m,l; bf16x8 pf[5]; chunk_softmax(S,m,l,pf);
  f32x4 O[4];
  #pragma unroll
  for(int d=0;d<4;++d)O[d]=(f32x4){0.f,0.f,0.f,0.f};
  const lds_cptr rb=(lds_cptr)wl+(4*g+(i16>>2))*VROW_F+(4*(i16&3))*2;
  #pragma unroll
  for(int tile=0;tile<2;++tile){
    #pragma unroll
    for(int it=0;it<16;++it){ const int row=it*4+g; const f32x4 v=*(const f32x4*)(cfv+((size_t)(b*PAST+j0+64*tile+row)*8+h)*64+4*i16);
      *(LAS unsigned long long*)(wl+row*VROW_F+i16*8)=(unsigned long long)attn::cvtpk_s(v[0],v[1])|((unsigned long long)attn::cvtpk_s(v[2],v[3])<<32); }
    #pragma unroll
    for(int G2=0;G2<2;++G2)
      #pragma unroll
      for(int d=0;d<4;++d){ const s16x4 lo=vtr(rb+(32*G2)*VROW_F+32*d), hi=vtr(rb+(32*G2+16)*VROW_F+32*d); O[d]=MF16(pf[2*tile+G2],pk8(lo,hi),O[d]); }
  }
  if(last){
    #pragma unroll
    for(int it=0;it<2;++it){ const int sl=it*64+lane,row=sl>>3,ch=sl&7; const u32x4 v=*(const u32x4*)(Pn+(size_t)row*NPROJ+C_FV+h*64+ch*8); *(LAS u32x4*)(wl+row*VROW_F+ch*16)=v; }
    #pragma unroll
    for(int d=0;d<4;++d){ const s16x4 lo=vtr(rb+32*d); O[d]=MF16(pf[4],pk8(lo,(s16x4){0,0,0,0}),O[d]); }
  }
  const size_t item=((size_t)(b*8+h)*NCH+c);
  float*po=(float*)(F.ws+WS_PART+PF_O)+item*(16*64);
  #pragma unroll
  for(int d=0;d<4;++d)
    #pragma unroll
    for(int r=0;r<4;++r)po[(4*g+r)*64+16*d+i16]=O[d][r];
  if(g==0){ ((float*)(F.ws+WS_PART+PF_M))[item*16+i16]=m; ((float*)(F.ws+WS_PART+PF_L))[item*16+i16]=l; }
}
__device__ __forceinline__ void diff_item(const Frame&F,int b,int h,int c,LAS unsigned char*wl,const LAS float*tb){
  const int lane=F.lane,i16=lane&15,g=lane>>4; const bool last=(c==NCH-1); const int j0=c*CHK;
  const bf16*Pn=(const bf16*)(F.ws+WS_P)+(size_t)(MP+b*TS)*NPROJ; const float*cdk=F.in[5]; const float*cdv=F.in[6];
  float m[2],l[2]; bf16x8 pf[2][5];
  #pragma unroll
  for(int mm=0;mm<2;++mm){
    bf16x8 qf[2];
    #pragma unroll
    for(int s=0;s<2;++s)qf[s]=*(const bf16x8*)(Pn+(size_t)i16*NPROJ+C_DQ+h*128+mm*64+32*s+8*g);
    f32x4 S[9];
    #pragma unroll
    for(int kb=0;kb<8;++kb){ const float*kr=cdk+(((size_t)(b*PAST+j0+16*kb+i16)*4+h)*2+mm)*64+8*g;
      const f32x4 a0=*(const f32x4*)kr,a1=*(const f32x4*)(kr+4),a2=*(const f32x4*)(kr+32),a3=*(const f32x4*)(kr+36);
      f32x4 acc=MF16(cvt8(a0,a1),qf[0],((f32x4){0.f,0.f,0.f,0.f})); S[kb]=MF16(cvt8(a2,a3),qf[1],acc); }
    if(last){ const bf16*kr=Pn+(size_t)i16*NPROJ+C_DK+h*128+mm*64+8*g;
      f32x4 acc=MF16(*(const bf16x8*)kr,qf[0],((f32x4){0.f,0.f,0.f,0.f})); S[8]=MF16(*(const bf16x8*)(kr+32),qf[1],acc);
      const LAS float*t0=tb+h*attn::TBN+(383-PAST-i16+j0+4*g);
      #pragma unroll
      for(int kb=0;kb<9;++kb)
        #pragma unroll
        for(int r=0;r<4;++r)S[kb][r]+=t0[16*kb+r]; }
    else S[8]=(f32x4){-INFINITY,-INFINITY,-INFINITY,-INFINITY};
    chunk_softmax(S,m[mm],l[mm],pf[mm]);
  }
  f32x4 O[2][8];
  #pragma unroll
  for(int mm=0;mm<2;++mm)
    #pragma unroll
    for(int d=0;d<8;++d)O[mm][d]=(f32x4){0.f,0.f,0.f,0.f};
  const lds_cptr rb=(lds_cptr)wl+(4*g+(i16>>2))*VROW_D+(4*(i16&3))*2;
  #pragma unroll
  for(int G=0;G<4;++G){
    #pragma unroll
    for(int it=0;it<16;++it){ const int row=it*2+(lane>>5),c4=lane&31; const f32x4 v=*(const f32x4*)(cdv+((size_t)(b*PAST+j0+32*G+row)*4+h)*128+4*c4);
      *(LAS unsigned long long*)(wl+row*VROW_D+c4*8)=(unsigned long long)attn::cvtpk_s(v[0],v[1])|((unsigned long long)attn::cvtpk_s(v[2],v[3])<<32); }
    #pragma unroll
    for(int d=0;d<8;++d){ const s16x4 lo=vtr(rb+32*d), hi=vtr(rb+16*VROW_D+32*d); const bf16x8 vf=pk8(lo,hi); O[0][d]=MF16(pf[0][G],vf,O[0][d]); O[1][d]=MF16(pf[1][G],vf,O[1][d]); }
  }
  if(last){
    #pragma unroll
    for(int it=0;it<4;++it){ const int sl=it*64+lane,row=sl>>4,ch=sl&15; const u32x4 v=*(const u32x4*)(Pn+(size_t)row*NPROJ+C_DV+h*128+ch*8); *(LAS u32x4*)(wl+row*VROW_D+ch*16)=v; }
    #pragma unroll
    for(int d=0;d<8;++d){ const s16x4 lo=vtr(rb+32*d); const bf16x8 vf=pk8(lo,(s16x4){0,0,0,0}); O[0][d]=MF16(pf[0][4],vf,O[0][d]); O[1][d]=MF16(pf[1][4],vf,O[1][d]); }
  }
  const size_t item=((size_t)(b*4+h)*NCH+c);
  #pragma unroll
  for(int mm=0;mm<2;++mm){ float*po=(float*)(F.ws+WS_PART+PD_O)+(item*2+mm)*(16*128);
    #pragma unroll
    for(int d=0;d<8;++d)
      #pragma unroll
      for(int r=0;r<4;++r)po[(4*g+r)*128+16*d+i16]=O[mm][d][r];
    if(g==0){ ((float*)(F.ws+WS_PART+PD_M))[(item*2+mm)*16+i16]=m[mm]; ((float*)(F.ws+WS_PART+PD_L))[(item*2+mm)*16+i16]=l[mm]; } }
}
#undef MF16
__device__ __forceinline__ void sample_phase(const Frame&F){
  LAS unsigned char*wl=F.lds+F.wave*WLDS; const LAS float*tb=(const LAS float*)(F.lds+attn::LDS_TB);
  constexpr int ND=32*4*NCH, NF=32*8*NCH;
  for(int it=F.gw;it<ND+NF;it+=F.ngw){
    if(it<ND){ const int c=it%NCH,bh=it/NCH; diff_item(F,bh>>2,bh&3,c,wl,tb); }
    else { const int u=it-ND,c=u%NCH,bh=u/NCH; fox_item(F,bh>>3,bh&7,c,wl); }
  }
}
__device__ __forceinline__ void sample_merge_phase(const Frame&F){
  const bf16*P=(const bf16*)(F.ws+WS_P); bf16*Y=(bf16*)(F.ws+WS_Y); const float*sg=F.in[14]; const int lane=F.lane;
  const float lam=expf(wave_sum(F.in[10][lane]*F.in[11][lane]))-expf(wave_sum(F.in[12][lane]*F.in[13][lane]))+0.2f;
  for(int it=F.gw;it<MS*12;it+=F.ngw){
    if(it<MS*8){ const int h=it&7,ms=it>>3,b=ms>>4,q=ms&15; const size_t i0=(size_t)(b*8+h)*NCH;
      const float*pm=(const float*)(F.ws+WS_PART+PF_M),*pl=(const float*)(F.ws+WS_PART+PF_L),*po=(const float*)(F.ws+WS_PART+PF_O);
      float M=-INFINITY;
      for(int c=0;c<NCH;++c)M=fmaxf(M,pm[(i0+c)*16+q]);
      float L=0.f,o=0.f;
      for(int c=0;c<NCH;++c){ const float w=exp2f(pm[(i0+c)*16+q]-M); L+=w*pl[(i0+c)*16+q]; o+=w*po[(i0+c)*1024+q*64+lane]; }
      const size_t m=(size_t)MP+ms; Y[m*DM+h*64+lane]=(bf16)f2bf(o/L*bf2f(P[m*NPROJ+C_FZ+h*64+lane]));
    } else { const int u=it-MS*8,h=u&3,ms=u>>2,b=ms>>4,q=ms&15; const size_t i0=(size_t)(b*4+h)*NCH;
      const float*pm=(const float*)(F.ws+WS_PART+PD_M),*pl=(const float*)(F.ws+WS_PART+PD_L),*po=(const float*)(F.ws+WS_PART+PD_O);
      float od[2][2];
      #pragma unroll
      for(int mm=0;mm<2;++mm){ float M=-INFINITY;
        for(int c=0;c<NCH;++c)M=fmaxf(M,pm[((i0+c)*2+mm)*16+q]);
        float L=0.f,o0=0.f,o1=0.f;
        for(int c=0;c<NCH;++c){ const float w=exp2f(pm[((i0+c)*2+mm)*16+q]-M); L+=w*pl[((i0+c)*2+mm)*16+q]; o0+=w*po[((i0+c)*2+mm)*2048+q*128+lane]; o1+=w*po[((i0+c)*2+mm)*2048+q*128+64+lane]; }
        od[mm][0]=o0/L; od[mm][1]=o1/L; }
      const float d0=od[0][0]-lam*od[1][0],d1=od[0][1]-lam*od[1][1];
      const float r=1.0f/sqrtf(wave_sum(d0*d0+d1*d1)*(1.f/128.f)+NORM_EPS);
      const size_t m=(size_t)MP+ms;
      Y[m*DM+512+h*128+lane]=(bf16)f2bf(d0*r*sg[lane]*0.8f*bf2f(P[m*NPROJ+C_DZ+h*128+lane]));
      Y[m*DM+512+h*128+64+lane]=(bf16)f2bf(d1*r*sg[64+lane]*0.8f*bf2f(P[m*NPROJ+C_DZ+h*128+64+lane]));
    }
  }
}
}

__device__ __forceinline__ void attn_table_build(const Frame& F) {
    LAS float* tb = (LAS float*)(F.lds + attn::LDS_TB); const float* relb = F.in[18];
    for (int i = F.tid; i < 4 * attn::TBN; i += 512) { const int h = i / attn::TBN, rel = i % attn::TBN - 383; tb[i] = (relb[t5_bucket(rel) * 4 + h] - relb[15 * 4 + h]) * LOG2E; }
    __syncthreads();
}
__device__ __forceinline__ void attn_prompt_phase(const Frame& F, char* shm) {
    const bf16* P = (const bf16*)(F.ws + WS_P); bf16* Y = (bf16*)(F.ws + WS_Y); bf16* OD = (bf16*)(F.ws + WS_XN);
    const bf16* QX = (const bf16*)(F.ws + WS_QX); const bf16* KX = (const bf16*)(F.ws + WS_KX);
    { if (F.tid < 3 * 64) { const int sl = F.tid >> 6, row = F.tid & 63;
          *(LAS u32x4*)(F.lds + attn::LDS_K + sl * attn::SLOTB + 9216 + row * 16) = (u32x4){0x3F803F80u, 0x00003F80u, 0u, 0u}; }
      __syncthreads(); }
    const int G = gridDim.x, bx = blockIdx.x;
    const int nd = 32 * 16 * 4, nf = 64 * 16;
    if (G == 256) {
        const int vcu = (bx & 7) * 32 + (bx >> 3);
        { const int bh = vcu >> 3, b = bh >> 2, h = bh & 3, s = vcu & 7;
          for (int i = 0; i < 8; ++i) { const int qb = (i >> 2) ? 15 - s : s, mm = i & 1, vh = (i >> 1) & 1; const size_t rb = (size_t)b * TP;
              attn::attn_unit<false, 8>(qb, P + rb * NPROJ + C_DQ + h * 128 + mm * 64, P + rb * NPROJ + C_DK + h * 128 + mm * 64, P + rb * NPROJ + C_DV + h * 128 + vh * 64, nullptr, nullptr,
                                        OD + rb * DM + h * 256 + mm * 128 + vh * 64, DM, nullptr, h, shm); } }
        { const int st = vcu >> 2, b = st >> 3, h = st & 7;
          for (int i = 0; i < 4; ++i) { const int s = 2 * (vcu & 3) + (i >> 1), qb = (i & 1) ? 15 - s : s; const size_t rb = (size_t)b * TP;
              attn::attn_unit<true, 20>(qb, P + rb * NPROJ + C_FQ + h * 64, P + rb * NPROJ + C_FK + h * 64, P + rb * NPROJ + C_FV + h * 64, QX + rb * 64 + h * 8, KX + rb * 64 + h * 8,
                                        Y + rb * DM + h * 64, DM, P + rb * NPROJ + C_FZ + h * 64, 0, shm); } }
    } else {
        for (int u = bx; u < nd; u += G) { const int sub = u & 3, qb = (u >> 2) & 15, bh = u >> 6, b = bh >> 2, h = bh & 3, mm = sub & 1, vh = sub >> 1; const size_t rb = (size_t)b * TP;
            attn::attn_unit<false, 8>(qb, P + rb * NPROJ + C_DQ + h * 128 + mm * 64, P + rb * NPROJ + C_DK + h * 128 + mm * 64, P + rb * NPROJ + C_DV + h * 128 + vh * 64, nullptr, nullptr,
                                      OD + rb * DM + h * 256 + mm * 128 + vh * 64, DM, nullptr, h, shm); }
        for (int u = bx; u < nf; u += G) { const int qb = u & 15, st = u >> 4, b = st >> 3, h = st & 7; const size_t rb = (size_t)b * TP;
            attn::attn_unit<true, 20>(qb, P + rb * NPROJ + C_FQ + h * 64, P + rb * NPROJ + C_FK + h * 64, P + rb * NPROJ + C_FV + h * 64, QX + rb * 64 + h * 8, KX + rb * 64 + h * 8,
                                      Y + rb * DM + h * 64, DM, P + rb * NPROJ + C_FZ + h * 64, 0, shm); }
    }
}
__device__ __forceinline__ void diff_combine_phase(const Frame& F) {
    const bf16* P = (const bf16*)(F.ws + WS_P); bf16* Y = (bf16*)(F.ws + WS_Y); const bf16* OD = (const bf16*)(F.ws + WS_XN); const float* sg = F.in[14];
    const int lane = F.lane, h = lane >> 4, e0 = (lane & 15) * 8;
    const float lam = expf(wave_sum(F.in[10][lane] * F.in[11][lane])) - expf(wave_sum(F.in[12][lane] * F.in[13][lane])) + 0.2f;
    float g[8];
#pragma unroll
    for (int i = 0; i < 8; ++i) g[i] = sg[e0 + i] * 0.8f;
    for (int m = F.gw; m < MP; m += F.ngw) {
        const u32x4 a = *(const u32x4*)(OD + (size_t)m * DM + h * 256 + e0), b = *(const u32x4*)(OD + (size_t)m * DM + h * 256 + 128 + e0);
        const u32x4 z = *(const u32x4*)(P + (size_t)m * NPROJ + C_DZ + h * 128 + e0);
        float d[8]; d[0] = bflo(a.x) - lam * bflo(b.x); d[1] = bfhi(a.x) - lam * bfhi(b.x); d[2] = bflo(a.y) - lam * bflo(b.y); d[3] = bfhi(a.y) - lam * bfhi(b.y);
        d[4] = bflo(a.z) - lam * bflo(b.z); d[5] = bfhi(a.z) - lam * bfhi(b.z); d[6] = bflo(a.w) - lam * bflo(b.w); d[7] = bfhi(a.w) - lam * bfhi(b.w);
        float ss = 0.f;
#pragma unroll
        for (int i = 0; i < 8; ++i) ss += d[i] * d[i];
        ss += __shfl_xor(ss, 1); ss += __shfl_xor(ss, 2); ss += __shfl_xor(ss, 4); ss += __shfl_xor(ss, 8);
        const float r = 1.0f / sqrtf(ss * (1.f / 128.f) + NORM_EPS);
        u32x4 w; w.x = pk2(d[0] * r * g[0] * bflo(z.x), d[1] * r * g[1] * bfhi(z.x)); w.y = pk2(d[2] * r * g[2] * bflo(z.y), d[3] * r * g[3] * bfhi(z.y));
        w.z = pk2(d[4] * r * g[4] * bflo(z.z), d[5] * r * g[5] * bfhi(z.z)); w.w = pk2(d[6] * r * g[6] * bflo(z.w), d[7] * r * g[7] * bfhi(z.w));
        *(u32x4*)(Y + (size_t)m * DM + 512 + h * 128 + e0) = w;
    }
}

__device__ __forceinline__ void final_norm_phase(const Frame& F) {
    const float* gf = F.in[19];
    for (int m = F.gw; m < MT; m += F.ngw) {
        float* row = F.out + (size_t)m * DM; f32x4 v[4]; float ss = 0.f;
#pragma unroll
        for (int j = 0; j < 4; ++j) { v[j] = *(const f32x4*)(row + 4 * (F.lane + 64 * j)); ss += (v[j][0] * v[j][0] + v[j][1] * v[j][1]) + (v[j][2] * v[j][2] + v[j][3] * v[j][3]); }
        const float rstd = 1.0f / sqrtf(wave_sum(ss) * (1.f / DM) + NORM_EPS);
#pragma unroll
        for (int j = 0; j < 4; ++j) { const f32x4 g = *(const f32x4*)(gf + 4 * (F.lane + 64 * j)); *(f32x4*)(row + 4 * (F.lane + 64 * j)) = v[j] * rstd * g; }
    }
}

#ifndef MK_COOP
#define MK_COOP 1
#endif
#ifndef PROBE_REPEAT
#define PROBE_REPEAT -1
#endif
#ifndef MK_CGSYNC
#define MK_CGSYNC 0
#endif
#ifndef MK_MULTI
#define MK_MULTI 0
#endif
__global__ void __launch_bounds__(512, 2) fwd_kernel(Params p) {
    extern __shared__ __attribute__((aligned(16))) unsigned char lds_raw[];
    cg::grid_group grid = cg::this_grid();
    Frame F; F.lds = (LAS unsigned char*)lds_raw; F.tid = threadIdx.x; F.lane = F.tid & 63; F.wave = __builtin_amdgcn_readfirstlane(F.tid >> 6);
    F.gw = blockIdx.x * 8 + F.wave; F.ngw = gridDim.x * 8; F.in = p.in; F.out = p.out; F.ws = p.ws;
    const int lo = p.ph_lo, hi = p.ph_hi;
    volatile LAS unsigned* misc = (volatile LAS unsigned*)(F.lds + LDS_BYTES - 64);
    if (F.tid < 16) misc[F.tid] = 0u;
    __syncthreads();
    XcdBarrier bar; bar.bar = (unsigned*)(p.ws + WS_CTL) + 4096; bar.x = 0; bar.st = nullptr;
    if (hi - lo > 1) bar = xcd_barrier_post((unsigned*)(p.ws + WS_CTL) + 4096, misc);
#define IN(k) (lo <= (k) && (k) < hi)
#if MK_CGSYNC
#define SEAM(k) do { if (IN(k) && IN((k) + 1)) grid.sync(); } while (0)
#else
#define SEAM(k) do { if (IN(k) && IN((k) + 1)) xcd_barrier(bar); } while (0)
#endif
    bf16* XN = (bf16*)(p.ws + WS_XN); bf16* Pb = (bf16*)(p.ws + WS_P); bf16* Y = (bf16*)(p.ws + WS_Y); bf16* T = (bf16*)(p.ws + WS_XN); bf16* MG = (bf16*)(p.ws + WS_MG);
    if (IN(0)) phase0(F);
    SEAM(0);
    if (IN(1)) {
        scan_phase(F);
        pg8::Gemm g{XN, (const bf16*)(p.ws + WS_WIN), MT, NPROJ, DM, DM, DM}; pg8::StaticOrder S; S.init(MT, NPROJ, (int)gridDim.x, (int)blockIdx.x);
        pg8::EpiProj E{Pb, p.out};
        pg8::gemm_phase<pg8::EpiProj, pg8::StaticOrder, true, true>(F.lds, g, S, E);
    }
    SEAM(1);
    const bool samp_first = (blockIdx.x >> 3) & 1;
    if (IN(2) || IN(3)) attn_table_build(F);
    if (IN(2) && (samp_first || !IN(3))) { samp::sample_phase(F); __syncthreads(); }
    if (IN(3)) attn_prompt_phase(F, (char*)lds_raw);
    if (IN(2) && !(samp_first || !IN(3))) { __syncthreads(); samp::sample_phase(F); __syncthreads(); }
    SEAM(3);
    if (IN(4)) { diff_combine_phase(F);
#if !NAIVE_SAMPLE
        samp::sample_merge_phase(F);
#endif
    }
    SEAM(4);
    if (IN(5)) {
        { pg8::Gemm g{Y, (const bf16*)(p.ws + WS_WF), MT, DM, 512, DM, 512}; pg8::StaticOrder S; S.init(MT, DM, (int)gridDim.x, (int)blockIdx.x);
          pg8::EpiT E{Pb, T}; pg8::gemm_phase<pg8::EpiT, pg8::StaticOrder, true, true>(F.lds, g, S, E); }
        { pg8::Gemm g{Y + 512, (const bf16*)(p.ws + WS_WD), MT, DM, 512, DM, 512}; pg8::StaticOrder S; S.init(MT, DM, (int)gridDim.x, (int)blockIdx.x);
          pg8::EpiMG E{Pb, T, MG}; pg8::gemm_phase<pg8::EpiMG, pg8::StaticOrder, true, true>(F.lds, g, S, E); }
    }
    SEAM(5);
    if (IN(6)) {
        pg8::Gemm g{MG, (const bf16*)(p.ws + WS_WO), MT, DM, DM, DM, DM}; pg8::StaticOrder S; S.init(MT, DM, (int)gridDim.x, (int)blockIdx.x);
        pg8::EpiOut E{p.in[0], p.in[1], p.out}; pg8::gemm_phase<pg8::EpiOut, pg8::StaticOrder, true, true>(F.lds, g, S, E);
    }
    SEAM(6);
    if (IN(7)) final_norm_phase(F);
#undef IN
#undef SEAM
}

extern "C" void kernel_launch(void* const* d_in, const int* in_sizes, int n_in, void* d_out, int out_size, void* d_ws, size_t ws_size, hipStream_t stream) {
    static int grid = 0;
    if (grid == 0) {
        if (n_in != 20 || (size_t)out_size != O_END || ws_size < WS_END) { fprintf(stderr, "kernel_launch: unexpected shapes (n_in %d out %d ws %zu)\n", n_in, out_size, ws_size); grid = -1; return; }
        int dev = 0, cus = 0, per_cu = 0;
        hipGetDevice(&dev); hipDeviceGetAttribute(&cus, hipDeviceAttributeMultiprocessorCount, dev);
        if (hipFuncSetAttribute((const void*)fwd_kernel, hipFuncAttributeMaxDynamicSharedMemorySize, LDS_BYTES) != hipSuccess) { fprintf(stderr, "kernel_launch: hipFuncSetAttribute failed\n"); grid = -1; return; }
        if (hipOccupancyMaxActiveBlocksPerMultiprocessor(&per_cu, (const void*)fwd_kernel, 512, LDS_BYTES) != hipSuccess || per_cu < 1) { fprintf(stderr, "kernel_launch: occupancy query failed (%d)\n", per_cu); per_cu = 1; }
        (void)hipGetLastError();
        grid = cus * 1;
        fprintf(stderr, "kernel_launch: cus %d per_cu %d grid %d\n", cus, per_cu, grid);
    }
    if (grid < 0) return;
    if (hipMemsetAsync((char*)d_ws + WS_CTL, 0, 65536, stream) != hipSuccess) { fprintf(stderr, "kernel_launch: hipMemsetAsync failed\n"); return; }
    Params p{};
    for (int i = 0; i < 20; ++i) p.in[i] = (const float*)d_in[i];
    p.out = (float*)d_out; p.ws = (unsigned char*)d_ws;
#if PROBE_REPEAT >= 0
    { const int cuts[4][2] = {{0, PROBE_REPEAT + 1}, {PROBE_REPEAT, PROBE_REPEAT + 1}, {PROBE_REPEAT + 1, NPHASE}, {0, 0}};
      for (int li = 0; li < 3; ++li) { if (li) (void)hipMemsetAsync((char*)d_ws + WS_CTL, 0, 65536, stream); p.ph_lo = cuts[li][0]; p.ph_hi = cuts[li][1]; hipLaunchKernelGGL(fwd_kernel, dim3(grid), dim3(512), LDS_BYTES, stream, p); } }
#elif MK_MULTI
    for (int ph = 0; ph < NPHASE; ++ph) { p.ph_lo = ph; p.ph_hi = ph + 1; hipLaunchKernelGGL(fwd_kernel, dim3(grid), dim3(512), LDS_BYTES, stream, p); }
#else
    p.ph_lo = 0; p.ph_hi = NPHASE;
#if MK_COOP
    void* args[] = {&p};
    hipError_t e = hipLaunchCooperativeKernel((const void*)fwd_kernel, dim3(grid), dim3(512), args, LDS_BYTES, stream);
    if (e != hipSuccess) fprintf(stderr, "kernel_launch: cooperative launch failed: %s (grid %d)\n", hipGetErrorString(e), grid);
#else
    hipLaunchKernelGGL(fwd_kernel, dim3(grid), dim3(512), LDS_BYTES, stream, p);
#endif
#endif
}
```
